# Optimizing an MI355X kernel written in HIP

```python
import jax, jax.numpy as jnp
from jax import lax
import numpy as np

D_MODEL = 1024
BATCH = 8
SEQ = 2048
DEPTH = 4
DEC_BATCH = 128
DEC_SEQ = 4
PAST_LEN = 16384
PAGE_SIZE = 128

N_MIXERS = 3
N_A = (DEPTH + 2) // N_MIXERS
N_B = (DEPTH + 1) // N_MIXERS
N_C = DEPTH // N_MIXERS
CHUNK = 128
A_INNER = 2 * D_MODEL
A_HEADS = 8
A_GROUP = A_INNER // A_HEADS
HEAD_SIZE = 64
B_HEADS = D_MODEL // HEAD_SIZE
DECAY_LORA = 64
ICLR_LORA = 64
GATE_LORA = 128
CONV_W = 3
D_FF = 2816
PLE_DIM = 256
ALPHA = (2 * DEPTH) ** 0.25
BETA = (8 * DEPTH) ** -0.25
LN_EPS = 1e-5
GN_EPS = 64e-5

kernel_name = 'hybrid_gmlp_rwkv7_shortconv_macaron_step'


def layer_norm(x, g, b, eps=LN_EPS):
    xf = x.astype(jnp.float32)
    mu = jnp.mean(xf, -1, keepdims=True)
    var = jnp.mean(jnp.square(xf - mu), -1, keepdims=True)
    return ((xf - mu) * lax.rsqrt(var + eps) * g + b).astype(x.dtype)


def swiglu(x, w_in, w_out):
    gate, up = jnp.split(x @ w_in, 2, axis=-1)
    return (jax.nn.silu(gate) * up) @ w_out


def gmlp_mixer(x, w_in, b_in, ln_g, ln_b, w_s, b_s, w_out):
    bn, t, _ = x.shape
    l = min(t, CHUNK)
    z = jax.nn.gelu(x @ w_in + b_in, approximate=False)
    u, v = jnp.split(z, 2, axis=-1)
    v = layer_norm(v, ln_g, ln_b)
    mask = jnp.tril(jnp.ones((l, l), dtype=bool))
    ws = jnp.where(mask, w_s[:, :l, :l], 0.0).astype(v.dtype)
    vc = v.reshape(bn, t // l, l, A_HEADS, A_GROUP)
    mixed = jnp.einsum('hts,bcshg->bcthg', ws, vc) + b_s[:, :l].T[None, None, :, :, None]
    y = u * mixed.reshape(bn, t, A_INNER).astype(u.dtype)
    return y @ w_out, v


def rwkv7_mixer(x, shift_prev, s0, mu, w_rkv, w0, w1, w2, a0, a1, a2, g1, g2, k_k, k_a, r_k, lnx_g, lnx_b, w_o):
    f32 = jnp.float32
    bn, t, d = x.shape
    x_prev = jnp.concatenate([shift_prev[:, None].astype(x.dtype), x[:, :-1]], axis=1)
    xx = x_prev - x
    xr, xw, xk, xv, xa, xg = [x + xx * mu[i] for i in range(6)]
    rkv = jnp.einsum('pbtd,pde->pbte', jnp.stack([xr, xk, xv]), w_rkv)
    r, k, v = rkv[0], rkv[1], rkv[2]
    w_log = -jax.nn.softplus(-(w0 + jnp.tanh(xw @ w1) @ w2).astype(f32)) - 0.5
    decay = jnp.exp(-jnp.exp(w_log))
    a = jax.nn.sigmoid((a0 + (xa @ a1) @ a2).astype(f32))
    g = jax.nn.sigmoid(xg @ g1) @ g2
    heads = lambda z: z.reshape(bn, t, B_HEADS, HEAD_SIZE)
    kk = heads((k * k_k).astype(f32))
    kk = kk / jnp.maximum(jnp.sqrt(jnp.sum(jnp.square(kk), -1, keepdims=True)), 1e-12)
    kmod = k.astype(f32) * (1.0 + (a - 1.0) * k_a)
    rh, kh, vh, wh, ah = heads(r.astype(f32)), heads(kmod), heads(v.astype(f32)), heads(decay), heads(a)

    def step(s, inp):
        r_t, w_t, k_t, v_t, kk_t, a_t = inp
        sa = jnp.einsum('bhvk,bhk->bhv', s, -kk_t)
        s = s * w_t[:, :, None, :] + sa[..., None] * (kk_t * a_t)[:, :, None, :] + v_t[..., None] * k_t[:, :, None, :]
        return s, jnp.einsum('bhvk,bhk->bhv', s, r_t)

    seq = tuple(jnp.moveaxis(z, 1, 0) for z in (rh, wh, kh, vh, kk, ah))
    s_fin, ys = lax.scan(step, s0.astype(f32), seq)
    ys = jnp.moveaxis(ys, 0, 1)
    m = jnp.mean(ys, -1, keepdims=True)
    var = jnp.mean(jnp.square(ys - m), -1, keepdims=True)
    yn = ((ys - m) * lax.rsqrt(var + GN_EPS)).reshape(bn, t, d) * lnx_g + lnx_b
    bonus = (jnp.sum(rh * kh * r_k, -1, keepdims=True) * vh).reshape(bn, t, d)
    out = ((yn + bonus).astype(x.dtype) * g) @ w_o
    return out, x[:, -1].astype(shift_prev.dtype), s_fin.astype(s0.dtype)


def conv_mixer(x, buf_prev, w_in, conv_w, w_out):
    t = x.shape[1]
    bg, cg, xin = jnp.split(x @ w_in, 3, axis=-1)
    z = cg * xin
    zp = jnp.concatenate([buf_prev.astype(z.dtype), z], axis=1)
    conv = conv_w[0] * zp[:, 0:t] + conv_w[1] * zp[:, 1:t + 1] + conv_w[2] * zp[:, 2:t + 2]
    return (bg * conv) @ w_out, zp[:, -(CONV_W - 1):].astype(buf_prev.dtype)


def run_trunk(x, p, b_wkv, b_shift, c_conv, W, keep_chunk_state):
    new_a_v, new_wkv, new_shift, new_conv = [], [], [], []
    for i in range(DEPTH):
        j = i // N_MIXERS
        kind = i % N_MIXERS
        x = layer_norm(ALPHA * x + 0.5 * swiglu(x, W['ffn_w_in'][i, 0], W['ffn_w_out'][i, 0]), W['ln_g'][i, 0], W['ln_b'][i, 0])
        if kind == 0:
            h, v = gmlp_mixer(x, W['a_w_in'][j], W['a_b_in'][j], W['a_ln_g'][j], W['a_ln_b'][j], W['a_w_s'][j], W['a_b_s'][j], W['a_w_out'][j])
            if keep_chunk_state:
                new_a_v.append(v)
        elif kind == 1:
            h, sh, s = rwkv7_mixer(x, b_shift[j], b_wkv[j], W['b_mu'][j], W['b_w_rkv'][j], W['b_w0'][j], W['b_w1'][j], W['b_w2'][j],
                                   W['b_a0'][j], W['b_a1'][j], W['b_a2'][j], W['b_g1'][j], W['b_g2'][j], W['b_k_k'][j], W['b_k_a'][j],
                                   W['b_r_k'][j], W['b_lnx_g'][j], W['b_lnx_b'][j], W['b_w_o'][j])
            new_shift.append(sh)
            new_wkv.append(s)
        else:
            h, buf = conv_mixer(x, c_conv[j], W['c_w_in'][j], W['c_conv_w'][j], W['c_w_out'][j])
            new_conv.append(buf)
        x = layer_norm(ALPHA * x + h, W['ln_g'][i, 1], W['ln_b'][i, 1])
        x = layer_norm(ALPHA * x + 0.5 * swiglu(x, W['ffn_w_in'][i, 1], W['ffn_w_out'][i, 1]), W['ln_g'][i, 2], W['ln_b'][i, 2])
        x = x + jax.nn.sigmoid(x @ W['ple_w_gate'][i]) * (p[i].astype(x.dtype) @ W['ple_w_proj'][i])
    a_state = jnp.stack(new_a_v) if keep_chunk_state else None
    return x, a_state, jnp.stack(new_wkv), jnp.stack(new_shift), jnp.stack(new_conv)


def setup_inputs(seed: int = 0) -> dict:
    key = jax.random.key(seed)
    kit = iter(jax.random.split(key, 64))
    D = D_MODEL

    def nrm(shape, scale):
        return scale * jax.random.normal(next(kit), shape, jnp.float32)

    return {
        'x_prompt': nrm((BATCH, SEQ, D), 1.0),
        'x_sample': nrm((DEC_BATCH, DEC_SEQ, D), 1.0),
        'state_b_wkv': nrm((N_B, DEC_BATCH, B_HEADS, HEAD_SIZE, HEAD_SIZE), 0.5),
        'state_b_shift': nrm((N_B, DEC_BATCH, D), 1.0),
        'state_c_conv': nrm((N_C, DEC_BATCH, CONV_W - 1, D), 1.0),
        'p_prompt': nrm((DEPTH, BATCH, SEQ, PLE_DIM), 1.0),
        'p_sample': nrm((DEPTH, DEC_BATCH, DEC_SEQ, PLE_DIM), 1.0),
        'ln_g': 1.0 + nrm((DEPTH, 3, D), 0.02),
        'ln_b': nrm((DEPTH, 3, D), 0.02),
        'ffn_w_in': nrm((DEPTH, 2, D, 2 * D_FF), D ** -0.5),
        'ffn_w_out': nrm((DEPTH, 2, D_FF, D), BETA * D_FF ** -0.5),
        'ple_w_gate': nrm((DEPTH, D, D), D ** -0.5),
        'ple_w_proj': nrm((DEPTH, PLE_DIM, D), BETA * PLE_DIM ** -0.5),
        'a_w_in': nrm((N_A, D, 2 * A_INNER), D ** -0.5),
        'a_b_in': nrm((N_A, 2 * A_INNER), 0.02),
        'a_ln_g': 1.0 + nrm((N_A, A_INNER), 0.02),
        'a_ln_b': nrm((N_A, A_INNER), 0.02),
        'a_w_s': nrm((N_A, A_HEADS, CHUNK, CHUNK), CHUNK ** -0.5),
        'a_b_s': 1.0 + nrm((N_A, A_HEADS, CHUNK), 0.02),
        'a_w_out': nrm((N_A, A_INNER, D), BETA * A_INNER ** -0.5),
        'b_mu': jax.random.uniform(next(kit), (N_B, 6, D), jnp.float32),
        'b_w_rkv': nrm((N_B, 3, D, D), D ** -0.5),
        'b_w0': nrm((N_B, D), 0.5) - 1.0,
        'b_w1': nrm((N_B, D, DECAY_LORA), D ** -0.5),
        'b_w2': nrm((N_B, DECAY_LORA, D), 0.1 * DECAY_LORA ** -0.5),
        'b_a0': nrm((N_B, D), 0.1),
        'b_a1': nrm((N_B, D, ICLR_LORA), D ** -0.5),
        'b_a2': nrm((N_B, ICLR_LORA, D), 0.1 * ICLR_LORA ** -0.5),
        'b_g1': nrm((N_B, D, GATE_LORA), D ** -0.5),
        'b_g2': nrm((N_B, GATE_LORA, D), GATE_LORA ** -0.5),
        'b_k_k': 0.85 + nrm((N_B, D), 0.02),
        'b_k_a': 1.0 + nrm((N_B, D), 0.02),
        'b_r_k': nrm((N_B, B_HEADS, HEAD_SIZE), 0.1),
        'b_lnx_g': 1.0 + nrm((N_B, D), 0.02),
        'b_lnx_b': nrm((N_B, D), 0.02),
        'b_w_o': nrm((N_B, D, D), BETA * D ** -0.5),
        'c_w_in': nrm((N_C, D, 3 * D), D ** -0.5),
        'c_conv_w': nrm((N_C, CONV_W, D), CONV_W ** -0.5),
        'c_w_out': nrm((N_C, D, D), BETA * D ** -0.5),
    }


def reference(x_prompt, x_sample, state_b_wkv, state_b_shift, state_c_conv, p_prompt, p_sample,
              ln_g, ln_b, ffn_w_in, ffn_w_out, ple_w_gate, ple_w_proj,
              a_w_in, a_b_in, a_ln_g, a_ln_b, a_w_s, a_b_s, a_w_out,
              b_mu, b_w_rkv, b_w0, b_w1, b_w2, b_a0, b_a1, b_a2, b_g1, b_g2, b_k_k, b_k_a, b_r_k,
              b_lnx_g, b_lnx_b, b_w_o, c_w_in, c_conv_w, c_w_out):
    W = dict(ln_g=ln_g, ln_b=ln_b, ffn_w_in=ffn_w_in, ffn_w_out=ffn_w_out, ple_w_gate=ple_w_gate, ple_w_proj=ple_w_proj,
             a_w_in=a_w_in, a_b_in=a_b_in, a_ln_g=a_ln_g, a_ln_b=a_ln_b, a_w_s=a_w_s, a_b_s=a_b_s, a_w_out=a_w_out,
             b_mu=b_mu, b_w_rkv=b_w_rkv, b_w0=b_w0, b_w1=b_w1, b_w2=b_w2, b_a0=b_a0, b_a1=b_a1, b_a2=b_a2,
             b_g1=b_g1, b_g2=b_g2, b_k_k=b_k_k, b_k_a=b_k_a, b_r_k=b_r_k, b_lnx_g=b_lnx_g, b_lnx_b=b_lnx_b, b_w_o=b_w_o,
             c_w_in=c_w_in, c_conv_w=c_conv_w, c_w_out=c_w_out)
    bp = x_prompt.shape[0]
    zero_wkv = jnp.zeros((N_B, bp) + state_b_wkv.shape[2:], state_b_wkv.dtype)
    zero_shift = jnp.zeros((N_B, bp, D_MODEL), state_b_shift.dtype)
    zero_conv = jnp.zeros((N_C, bp, CONV_W - 1, D_MODEL), state_c_conv.dtype)
    y_prompt, _, wkv_p, shift_p, conv_p = run_trunk(x_prompt, p_prompt, zero_wkv, zero_shift, zero_conv, W, False)
    y_sample, a_v_s, wkv_s, shift_s, conv_s = run_trunk(x_sample, p_sample, state_b_wkv, state_b_shift, state_c_conv, W, True)
    return (y_prompt, y_sample, a_v_s, wkv_p, shift_p, conv_p, wkv_s, shift_s, conv_s)
```

```cpp
#include <hip/hip_runtime.h>
#include <hip/hip_cooperative_groups.h>
#include <cstdio>
namespace cg = cooperative_groups;

#define LAS __attribute__((address_space(3)))
typedef unsigned short bf16_t;
typedef short bf16x8 __attribute__((ext_vector_type(8)));
typedef float f32x4 __attribute__((ext_vector_type(4)));
typedef float f32x2 __attribute__((ext_vector_type(2)));
typedef unsigned u32x4 __attribute__((ext_vector_type(4)));
typedef unsigned u32x2 __attribute__((ext_vector_type(2)));

constexpr int D = 1024, MP = 16384, MS = 512, MT = MP + MS, DFF = 2816;
constexpr float ALPHA = 1.6817928305074290f;
constexpr int BM = 256, BK = 64, HALF = 128, HTB = HALF * BK * 2, STAGE_BYTES = 8 * HTB, NXCD = 8, WGM = 8;
constexpr int LDS_BYTES = STAGE_BYTES;

constexpr size_t SZ_ROWF = (size_t)MT * 1024 * 4;
constexpr size_t W_FFN_IN = 0;
constexpr size_t W_FFN_OUT = W_FFN_IN + (size_t)8 * 5632 * 1024 * 2;
constexpr size_t W_PLE_G = W_FFN_OUT + (size_t)8 * 1024 * 2816 * 2;
constexpr size_t W_PLE_P = W_PLE_G + (size_t)4 * 1024 * 1024 * 2;
constexpr size_t W_A_IN = W_PLE_P + (size_t)4 * 1024 * 256 * 2;
constexpr size_t W_A_OUT = W_A_IN + (size_t)2 * 4096 * 1024 * 2;
constexpr size_t W_A_S = W_A_OUT + (size_t)2 * 1024 * 2048 * 2;
constexpr size_t W_B_IN = W_A_S + (size_t)2 * 8 * 128 * 128 * 2;
constexpr size_t W_B_L2 = W_B_IN + (size_t)3328 * 2048 * 2;
constexpr size_t W_B_O = W_B_L2 + (size_t)3072 * 256 * 2;
constexpr size_t W_C_IN = W_B_O + (size_t)1024 * 1024 * 2;
constexpr size_t W_C_OUT = W_C_IN + (size_t)3072 * 1024 * 2;
constexpr size_t A_XB = W_C_OUT + (size_t)1024 * 1024 * 2;
constexpr size_t A_ACT = A_XB + (size_t)MT * 1024 * 2;
constexpr size_t A_PB = A_ACT + (size_t)MT * 2816 * 2;
constexpr size_t A_PP = A_PB + (size_t)MT * 256 * 2;
constexpr size_t A_MIX = A_PP + SZ_ROWF;
constexpr size_t A_TAB = A_MIX + 4 * SZ_ROWF;
constexpr size_t WS_END = A_TAB + 65536;
constexpr size_t A_XBALT = A_MIX;
constexpr size_t A_U = A_MIX, A_V = A_MIX + (size_t)MT * 2048 * 2, A_VN = A_V + (size_t)MT * 2048 * 4, A_YB = A_ACT;
constexpr size_t A_R = A_MIX, A_DEC = A_MIX + 3 * SZ_ROWF, A_AA = A_ACT, A_GG = A_ACT + (size_t)MT * 1024 * 2, A_T = A_GG + (size_t)MT * 1024 * 2;
constexpr size_t A_XCAT = A_PP, A_OUTPRE = A_PP;
constexpr size_t A_Z = A_MIX, A_BG = A_MIX + SZ_ROWF, A_YC = A_ACT;
static_assert(A_VN + (size_t)MP * 2048 * 2 <= WS_END, "mix region");

constexpr size_t O_Y = 0, O_AV = (size_t)MT * 1024, O_WKVP = O_AV + (size_t)2 * 512 * 2048, O_SHP = O_WKVP + 524288, O_CVP = O_SHP + 8192,
                 O_WKVS = O_CVP + 16384, O_SHS = O_WKVS + 8388608, O_CVS = O_SHS + 131072;

struct Params { const float* in[39]; float* out; unsigned char* ws; };
struct Ctx { int tid; unsigned char* ws; float* out; };
__device__ __forceinline__ Ctx mkctx(const Params& p) { Ctx c; c.tid = threadIdx.x; c.ws = p.ws; c.out = p.out; asm volatile("" : "+v"(c.tid)); asm volatile("" : "+s"(c.ws)); asm volatile("" : "+s"(c.out)); return c; }
__device__ __forceinline__ int uload32(const void* p) { return __builtin_amdgcn_readfirstlane(*(const volatile int*)p); }
template <class T> __device__ __forceinline__ T* uloadp(const void* p) { const unsigned lo = (unsigned)uload32(p), hi = (unsigned)uload32((const char*)p + 4); return (T*)(((unsigned long long)hi << 32) | lo); }

__device__ __forceinline__ unsigned cvt_pk_bf16(float lo, float hi) { unsigned r; asm("v_cvt_pk_bf16_f32 %0, %1, %2" : "=v"(r) : "v"(lo), "v"(hi)); return r; }
__device__ __forceinline__ float bf2f(unsigned short b) { return __uint_as_float(((unsigned)b) << 16); }
__device__ __forceinline__ f32x4 bf4_to_f4(u32x2 w) { return (f32x4){__uint_as_float(w.x << 16), __uint_as_float(w.x & 0xffff0000u), __uint_as_float(w.y << 16), __uint_as_float(w.y & 0xffff0000u)}; }
__device__ __forceinline__ u32x2 f4_to_bf4(f32x4 v) { u32x2 w; w.x = cvt_pk_bf16(v[0], v[1]); w.y = cvt_pk_bf16(v[2], v[3]); return w; }
__device__ __forceinline__ float wave_sum(float v) {
#pragma unroll
    for (int o = 32; o >= 1; o >>= 1) v += __shfl_xor(v, o);
    return v; }
template <int CTRL> __device__ __forceinline__ float dppmov(float v) { return __int_as_float(__builtin_amdgcn_update_dpp(0, __float_as_int(v), CTRL, 0xF, 0xF, true)); }
__device__ __forceinline__ float red16(float v) { v += dppmov<0xB1>(v); v += dppmov<0x4E>(v); v += dppmov<0x141>(v); v += dppmov<0x140>(v); return v; }
__device__ __forceinline__ float sigmoidf_(float x) { return 1.0f / (1.0f + __expf(-x)); }
__device__ __forceinline__ float tanh_(float x) { const float e = __expf(-2.0f * fabsf(x)); const float t = (1.0f - e) / (1.0f + e); return x < 0.f ? -t : t; }
__device__ __forceinline__ float decay_(float w) { const float sp = fmaxf(-w, 0.f) + __logf(1.0f + __expf(-fabsf(w))); return __expf(-__expf(-sp - 0.5f)); }
__device__ __forceinline__ f32x2 gelu_pk(f32x2 v) {
    const f32x2 av = __builtin_elementwise_abs(v), d = av * 0.2316418882f + 1.0f;
    f32x2 t; t.x = __builtin_amdgcn_rcpf(d.x); t.y = __builtin_amdgcn_rcpf(d.y);
    f32x2 q = t * 0.5307027145f + (-0.7265760135f); q = q * t + 0.7107068705f; q = q * t + (-0.142248368f); q = q * t + 0.127414796f; q = q * t;
    const f32x2 s = (v * v) * (-0.72134752044f);
    f32x2 e; e.x = __builtin_amdgcn_exp2f(s.x); e.y = __builtin_amdgcn_exp2f(s.y);
    const f32x2 m = v * (q * e), r = v - m;
    f32x2 o; o.x = v.x < 0.f ? m.x : r.x; o.y = v.y < 0.f ? m.y : r.y; return o;
}
__device__ __forceinline__ f32x4 gelu4(f32x4 v) { f32x2 a = gelu_pk((f32x2){v[0], v[1]}), b = gelu_pk((f32x2){v[2], v[3]}); return (f32x4){a.x, a.y, b.x, b.y}; }

enum { EK_FFN1 = 0, EK_RES, EK_GELU_UV, EK_STORE, EK_CONVZ, EK_PLE, EK_BIN, EK_BL2 };
struct Epi { int kind; float* f0; bf16_t* h0; bf16_t* h1; const float* c0; const float* c1; float scale; int ld; };
struct GemmDesc { const bf16_t* A; const bf16_t* Bt; int lda, ldb, K, nN; Epi e; };
__device__ __forceinline__ Epi load_epi(const GemmDesc* g) { Epi e; e.kind = uload32(&g->e.kind); e.f0 = uloadp<float>(&g->e.f0); e.h0 = uloadp<bf16_t>(&g->e.h0); e.h1 = uloadp<bf16_t>(&g->e.h1);
    e.c0 = uloadp<const float>(&g->e.c0); e.c1 = uloadp<const float>(&g->e.c1); e.scale = __int_as_float(uload32(&g->e.scale)); e.ld = uload32(&g->e.ld); return e; }

template <int KIND> __device__ __forceinline__ void epi_elem(const Epi& e, int row, int col, f32x4 v0, f32x4 v1) {
    if (KIND == EK_FFN1) {
        f32x4 o;
#pragma unroll
        for (int j = 0; j < 4; ++j) o[j] = v0[j] * __builtin_amdgcn_rcpf(1.0f + __expf(-v0[j])) * v1[j];
        *(u32x2*)(e.h0 + (size_t)row * DFF + col) = f4_to_bf4(o);
    } else if (KIND == EK_RES) {
        float* p = e.f0 + (size_t)row * 1024 + col; const f32x4 x = *(const f32x4*)p; *(f32x4*)p = x * ALPHA + v0 * e.scale;
    } else if (KIND == EK_GELU_UV) {
        const f32x4 b = *(const f32x4*)(e.c0 + col); const f32x4 g = gelu4(v0 + b);
        if (col < 2048) *(u32x2*)(e.h0 + (size_t)row * 2048 + col) = f4_to_bf4(g);
        else *(f32x4*)(e.f0 + (size_t)row * 2048 + (col - 2048)) = g;
    } else if (KIND == EK_STORE) {
        *(f32x4*)(e.f0 + (size_t)row * e.ld + col) = v0;
    } else if (KIND == EK_CONVZ) {
        *(f32x4*)(e.f0 + (size_t)row * 1024 + col) = v0 * v1;
    } else if (KIND == EK_PLE) {
        float* p = e.f0 + (size_t)row * 1024 + col; f32x4 x = *(const f32x4*)p; const f32x4 pp = *(const f32x4*)(e.c0 + (size_t)row * 1024 + col);
#pragma unroll
        for (int j = 0; j < 4; ++j) x[j] += pp[j] * __builtin_amdgcn_rcpf(1.0f + __expf(-v0[j]));
        *(f32x4*)p = x; *(u32x2*)(e.h0 + (size_t)row * 1024 + col) = f4_to_bf4(x);
    } else if (KIND == EK_BIN) {
        if (col < 3072) { const int t = col >> 10; *(f32x4*)(e.f0 + (size_t)t * ((size_t)MT * 1024) + (size_t)row * 1024 + (col & 1023)) = v0; }
        else { const int c = col - 3072; f32x4 o;
            if (c < 64) { o[0] = tanh_(v0[0]); o[1] = tanh_(v0[1]); o[2] = tanh_(v0[2]); o[3] = tanh_(v0[3]); }
            else if (c < 128) o = v0;
            else { o[0] = sigmoidf_(v0[0]); o[1] = sigmoidf_(v0[1]); o[2] = sigmoidf_(v0[2]); o[3] = sigmoidf_(v0[3]); }
            *(u32x2*)(e.h0 + (size_t)row * 256 + c) = f4_to_bf4(o); }
    } else if (KIND == EK_BL2) {
        if (col < 1024) { const f32x4 w0 = *(const f32x4*)(e.c0 + col); f32x4 o;
#pragma unroll
            for (int j = 0; j < 4; ++j) o[j] = decay_(w0[j] + v0[j]);
            *(f32x4*)(e.f0 + (size_t)row * 1024 + col) = o;
        } else if (col < 2048) { const int c = col - 1024; const f32x4 a0 = *(const f32x4*)(e.c1 + c); f32x4 o;
#pragma unroll
            for (int j = 0; j < 4; ++j) o[j] = sigmoidf_(a0[j] + v0[j]);
            *(u32x2*)(e.h0 + (size_t)row * 1024 + c) = f4_to_bf4(o);
        } else { *(u32x2*)(e.h1 + (size_t)row * 1024 + (col - 2048)) = f4_to_bf4(v0); }
    }
}
template <int KIND> __device__ __forceinline__ void epi_big(const GemmDesc* gd, const f32x4 (&acc)[2][2][4][2], int pm, int pn, int wr, int wc, int fr, int fq) {
    constexpr bool PAIRED = (KIND == EK_FFN1 || KIND == EK_CONVZ);
    const Epi e = load_epi(gd);
#pragma unroll
    for (int ai = 0; ai < 2; ++ai)
#pragma unroll
        for (int m = 0; m < 4; ++m) {
            asm volatile("" ::: "memory");
            const int row = pm * BM + ai * HALF + wr * 64 + m * 16 + fr;
#pragma unroll
            for (int n = 0; n < 2; ++n) {
                if (PAIRED) epi_elem<KIND>(e, row, pn * 128 + wc * 32 + n * 16 + fq * 4, acc[ai][0][m][n], acc[ai][1][m][n]);
                else {
#pragma unroll
                    for (int bj = 0; bj < 2; ++bj) epi_elem<KIND>(e, row, pn * BM + bj * HALF + wc * 32 + n * 16 + fq * 4, acc[ai][bj][m][n], acc[ai][bj][m][n]);
                }
            }
        }
}

__device__ __forceinline__ int lds_byte(int r, int c) { const int st = (r >> 4) * 2 + (c >> 5), rr = r & 15, cc = c & 31, ob = rr * 64 + cc * 2; return st * 1024 + (ob ^ (((ob >> 9) & 1) << 5)); }
__device__ __forceinline__ void stage_rc(int b, int& R, int& C) { const int st = b / 1024, sb = b % 1024, swz = sb ^ (((sb >> 9) & 1) << 5); R = (st >> 1) * 16 + swz / 64; C = (st & 1) * 32 + (swz % 64) / 2; }
struct Unit { int pm, pn; };
struct StaticOrder {
    int nM, nN, nwg, G, c;
    __device__ void init(int nM_, int nN_, int G_, int c_) { nM = nM_; nN = nN_; nwg = nM * nN; G = G_; c = c_; }
    __device__ bool next(int i, Unit& u) const {
        const long L = (long)i * G + c; if (L >= nwg) return false;
        int wgid = (int)L; { const int q = nwg / NXCD, r = nwg % NXCD, xcd = wgid % NXCD, off = wgid / NXCD; wgid = (xcd < r ? xcd * (q + 1) : r * (q + 1) + (xcd - r) * q) + off; }
        const int nig = WGM * nN, gid = wgid / nig, fm = gid * WGM, gsz = (nM - fm) < WGM ? (nM - fm) : WGM;
        u.pm = fm + ((wgid % nig) % gsz); u.pn = (wgid % nig) / gsz; return true;
    }
};

__device__ __forceinline__ void gemm_big(LAS unsigned char* lds, const GemmDesc* gd) {
    int tid_ = threadIdx.x; asm volatile("" : "+v"(tid_));
    const int tid = tid_, wid = __builtin_amdgcn_readfirstlane(tid >> 6), lane = tid & 63, wr = wid >> 2, wc = wid & 3, fr = lane & 15, fq = lane >> 4;
    struct { const bf16_t* A; const bf16_t* Bt; int lda, ldb, K, nN; } g;
    g.A = uloadp<const bf16_t>(&gd->A); g.Bt = uloadp<const bf16_t>(&gd->Bt); g.lda = uload32(&gd->lda); g.ldb = uload32(&gd->ldb); g.K = uload32(&gd->K); g.nN = uload32(&gd->nN);
    const int ekind = uload32(&gd->e.kind);
    const int K = g.K, nt = K / BK;
    StaticOrder S; S.init(MP / BM, g.nN, gridDim.x, blockIdx.x);
    unsigned voffA[2], voffB[2];
#pragma unroll
    for (int i = 0; i < 2; ++i) { int R, C; stage_rc(tid * 16 + i * 8192, R, C); voffA[i] = (unsigned)(R * g.lda + C) * 2u; voffB[i] = (unsigned)(R * g.ldb + C) * 2u; }
    const size_t kstep = (size_t)(BK * 2);
    const size_t hstepA = (size_t)HALF * g.lda * 2, hstepB = (size_t)HALF * g.ldb * 2;
    const size_t tstepA = 2 * hstepA, tstepB = 2 * hstepB;
    const unsigned ldsw = (unsigned)wid * 1024u;
    const int aoff = lds_byte(wr * 64 + fr, fq * 8), boff = lds_byte(wc * 32 + fr, fq * 8);
#define PG8_SA(b, h) (((b) * 2 + (h)) * HTB)
#define PG8_SB(b, h) ((4 + (b) * 2 + (h)) * HTB)
#define PG8_STAGE(bufoff, gbase, voff) do { _Pragma("unroll") for (int _i = 0; _i < 2; ++_i) \
        __builtin_amdgcn_global_load_lds((const unsigned*)((const char*)(gbase) + (voff)[_i]), (LAS unsigned*)(lds + (bufoff) + ldsw + _i * 8192), 16, 0, 0); } while (0)
#define PG8_LDA(dst, b, h) do { _Pragma("unroll") for (int m = 0; m < 4; ++m) _Pragma("unroll") for (int k = 0; k < 2; ++k) dst[m][k] = *(const LAS bf16x8*)(lds + PG8_SA(b, h) + aoff + m * 2048 + k * 1024); } while (0)
#define PG8_LDB(dst, b, h) do { _Pragma("unroll") for (int n = 0; n < 2; ++n) _Pragma("unroll") for (int k = 0; k < 2; ++k) dst[n][k] = *(const LAS bf16x8*)(lds + PG8_SB(b, h) + boff + n * 2048 + k * 1024); } while (0)
#define PG8_MMA(ai, bj, At, Bt) do { __builtin_amdgcn_s_setprio(1); _Pragma("unroll") for (int m = 0; m < 4; ++m) _Pragma("unroll") for (int n = 0; n < 2; ++n) _Pragma("unroll") for (int k = 0; k < 2; ++k) \
        acc[ai][bj][m][n] = __builtin_amdgcn_mfma_f32_16x16x32_bf16(Bt[n][k], At[m][k], acc[ai][bj][m][n], 0, 0, 0); __builtin_amdgcn_s_setprio(0); } while (0)
#define PG8_WAIT_V(n) asm volatile("s_waitcnt vmcnt(" #n ")" ::: "memory")
#define PG8_WAIT_L(n) asm volatile("s_waitcnt lgkmcnt(" #n ")" ::: "memory")
#define PG8_BAR __builtin_amdgcn_s_barrier()
#define PG8_SCHED __builtin_amdgcn_sched_barrier(0)
    Unit cur, nxt; int ui = 0;
    if (!S.next(0, cur)) return;
    f32x4 acc[2][2][4][2];
#pragma unroll
    for (int a = 0; a < 2; ++a)
#pragma unroll
        for (int b = 0; b < 2; ++b)
#pragma unroll
            for (int m = 0; m < 4; ++m)
#pragma unroll
                for (int n = 0; n < 2; ++n) acc[a][b][m][n] = (f32x4){0.f, 0.f, 0.f, 0.f};
    bf16x8 At[4][2], B0[2][2], B1[2][2];
    const char* cA = (const char*)g.A + (size_t)cur.pm * tstepA; const char* cB = (const char*)g.Bt + (size_t)cur.pn * tstepB;
    PG8_STAGE(PG8_SB(0, 0), cB, voffB); PG8_STAGE(PG8_SA(0, 0), cA, voffA); PG8_STAGE(PG8_SB(0, 1), cB + hstepB, voffB); PG8_STAGE(PG8_SA(0, 1), cA + hstepA, voffA);
    if (wr == 1) PG8_BAR;
    PG8_WAIT_V(4); PG8_BAR;
    PG8_STAGE(PG8_SB(1, 0), cB + kstep, voffB); PG8_STAGE(PG8_SA(1, 0), cA + kstep, voffA); PG8_STAGE(PG8_SB(1, 1), cB + hstepB + kstep, voffB);
    PG8_WAIT_V(6); PG8_BAR;
    for (;;) {
        const bool has_next = S.next(ui + 1, nxt);
        const char* nA = has_next ? (const char*)g.A + (size_t)nxt.pm * tstepA : cA; const char* nB = has_next ? (const char*)g.Bt + (size_t)nxt.pn * tstepB : cB;
        for (int t = 0; t < nt; t += 2) {
            const bool last = (t == nt - 2);
            const char* a1 = cA + (size_t)(t + 1) * kstep;
            const char* a2 = last ? nA : cA + (size_t)(t + 2) * kstep; const char* b2 = last ? nB : cB + (size_t)(t + 2) * kstep;
            const char* a3 = a2 + kstep; const char* b3 = b2 + kstep;
            PG8_LDB(B0, 0, 0); PG8_SCHED; PG8_LDA(At, 0, 0); PG8_STAGE(PG8_SA(1, 1), a1 + hstepA, voffA);
            PG8_WAIT_L(8); PG8_BAR; PG8_WAIT_L(0); PG8_MMA(0, 0, At, B0); PG8_BAR; PG8_SCHED;
            PG8_LDB(B1, 0, 1); PG8_STAGE(PG8_SB(0, 0), b2, voffB);
            PG8_BAR; PG8_WAIT_L(0); PG8_MMA(0, 1, At, B1); PG8_BAR;
            PG8_LDA(At, 0, 1); PG8_STAGE(PG8_SA(0, 0), a2, voffA);
            PG8_BAR; PG8_WAIT_L(0); PG8_MMA(1, 0, At, B0); PG8_BAR; PG8_SCHED;
            PG8_STAGE(PG8_SB(0, 1), b2 + hstepB, voffB);
            PG8_WAIT_V(6); PG8_BAR; PG8_MMA(1, 1, At, B1); PG8_BAR;
            PG8_LDB(B0, 1, 0); PG8_SCHED; PG8_LDA(At, 1, 0); PG8_STAGE(PG8_SA(0, 1), a2 + hstepA, voffA);
            PG8_WAIT_L(8); PG8_BAR; PG8_WAIT_L(0); PG8_MMA(0, 0, At, B0); PG8_BAR; PG8_SCHED;
            PG8_LDB(B1, 1, 1); PG8_STAGE(PG8_SB(1, 0), b3, voffB);
            PG8_BAR; PG8_WAIT_L(0); PG8_MMA(0, 1, At, B1); PG8_BAR;
            PG8_LDA(At, 1, 1); PG8_STAGE(PG8_SA(1, 0), a3, voffA);
            PG8_BAR; PG8_WAIT_L(0); PG8_MMA(1, 0, At, B0); PG8_BAR; PG8_SCHED;
            PG8_STAGE(PG8_SB(1, 1), b3 + hstepB, voffB);
            PG8_WAIT_V(6); PG8_BAR; PG8_MMA(1, 1, At, B1); PG8_BAR;
        }
        switch (ekind) {
            case EK_FFN1: epi_big<EK_FFN1>(gd, acc, cur.pm, cur.pn, wr, wc, fr, fq); break;
            case EK_RES: epi_big<EK_RES>(gd, acc, cur.pm, cur.pn, wr, wc, fr, fq); break;
            case EK_GELU_UV: epi_big<EK_GELU_UV>(gd, acc, cur.pm, cur.pn, wr, wc, fr, fq); break;
            case EK_STORE: epi_big<EK_STORE>(gd, acc, cur.pm, cur.pn, wr, wc, fr, fq); break;
            case EK_CONVZ: epi_big<EK_CONVZ>(gd, acc, cur.pm, cur.pn, wr, wc, fr, fq); break;
            case EK_PLE: epi_big<EK_PLE>(gd, acc, cur.pm, cur.pn, wr, wc, fr, fq); break;
            case EK_BIN: epi_big<EK_BIN>(gd, acc, cur.pm, cur.pn, wr, wc, fr, fq); break;
            default: epi_big<EK_BL2>(gd, acc, cur.pm, cur.pn, wr, wc, fr, fq); break;
        }
        if (!has_next) break;
#pragma unroll
        for (int a = 0; a < 2; ++a)
#pragma unroll
            for (int b = 0; b < 2; ++b)
#pragma unroll
                for (int m = 0; m < 4; ++m)
#pragma unroll
                    for (int n = 0; n < 2; ++n) acc[a][b][m][n] = (f32x4){0.f, 0.f, 0.f, 0.f};
        cur = nxt; cA = nA; cB = nB; ++ui;
    }
    PG8_WAIT_V(0);
    if (wr == 0) PG8_BAR;
    PG8_BAR;
#undef PG8_SA
#undef PG8_SB
#undef PG8_STAGE
#undef PG8_LDA
#undef PG8_LDB
#undef PG8_MMA
#undef PG8_WAIT_V
#undef PG8_WAIT_L
#undef PG8_BAR
#undef PG8_SCHED
}

template <int KIND> __device__ __forceinline__ void small_epi(const Epi& e, int row, int col, f32x4 v0, f32x4 v1) { epi_elem<KIND>(e, row, col, v0, v1); }
__device__ __forceinline__ void gemm_small(LAS unsigned char* lds, const GemmDesc* gd) {
    int tid_ = threadIdx.x; asm volatile("" : "+v"(tid_));
    const int tid = tid_, wid = __builtin_amdgcn_readfirstlane(tid >> 6), lane = tid & 63, fr = lane & 15, fq = lane >> 4;
    struct { const bf16_t* A; const bf16_t* Bt; int lda, ldb, K, nN; } g;
    g.A = uloadp<const bf16_t>(&gd->A); g.Bt = uloadp<const bf16_t>(&gd->Bt); g.lda = uload32(&gd->lda); g.ldb = uload32(&gd->ldb); g.K = uload32(&gd->K); g.nN = uload32(&gd->nN);
    const int ekind = uload32(&gd->e.kind);
    const bool paired = (ekind == EK_FFN1 || ekind == EK_CONVZ);
    const int ncu = paired ? g.nN * 4 : g.nN * 4;
    const int nunits = 8 * ncu;
    const int kq = wid >> 1, nh = wid & 1;
    const int ks = g.K >> 2;
    LAS f32x4* P = (LAS f32x4*)lds;
    for (int su = (int)(gridDim.x - 1 - blockIdx.x); su < nunits; su += gridDim.x) {
        const int rp = su & 7, cu = su >> 3;
        const int row0 = MP + rp * 64;
        int brow[2];
#pragma unroll
        for (int j = 0; j < 2; ++j) { const int nb = nh * 2 + j;
            if (paired) { const int p0 = cu * 32; brow[j] = (p0 >> 7) * 256 + (nb >> 1) * 128 + (p0 & 127) + (nb & 1) * 16 + fr; }
            else brow[j] = cu * 64 + nb * 16 + fr; }
        const bf16_t* ap = g.A + (size_t)(row0 + fr) * g.lda + kq * ks + fq * 8;
        const bf16_t* bp0 = g.Bt + (size_t)brow[0] * g.ldb + kq * ks + fq * 8;
        const bf16_t* bp1 = g.Bt + (size_t)brow[1] * g.ldb + kq * ks + fq * 8;
        f32x4 acc[4][2];
#pragma unroll
        for (int m = 0; m < 4; ++m) { acc[m][0] = (f32x4){0.f, 0.f, 0.f, 0.f}; acc[m][1] = (f32x4){0.f, 0.f, 0.f, 0.f}; }
#pragma unroll 2
        for (int k = 0; k < ks; k += 32) {
            bf16x8 a[4], b[2];
#pragma unroll
            for (int m = 0; m < 4; ++m) a[m] = *(const bf16x8*)(ap + (size_t)(m * 16) * g.lda + k);
            b[0] = *(const bf16x8*)(bp0 + k); b[1] = *(const bf16x8*)(bp1 + k);
#pragma unroll
            for (int m = 0; m < 4; ++m) { acc[m][0] = __builtin_amdgcn_mfma_f32_16x16x32_bf16(b[0], a[m], acc[m][0], 0, 0, 0); acc[m][1] = __builtin_amdgcn_mfma_f32_16x16x32_bf16(b[1], a[m], acc[m][1], 0, 0, 0); }
        }
#pragma unroll
        for (int m = 0; m < 4; ++m)
#pragma unroll
            for (int j = 0; j < 2; ++j) P[((kq * 4 + m) * 4 + nh * 2 + j) * 64 + lane] = acc[m][j];
        __syncthreads();
        {   const int m = wid >> 1, s = wid & 1;
            f32x4 v0 = (f32x4){0.f, 0.f, 0.f, 0.f}, v1 = v0;
#pragma unroll
            for (int q = 0; q < 4; ++q) { v0 += P[((q * 4 + m) * 4 + s) * 64 + lane]; v1 += P[((q * 4 + m) * 4 + s + 2) * 64 + lane]; }
            const int row = row0 + m * 16 + fr;
            const int cA_ = paired ? cu * 32 + s * 16 + fq * 4 : cu * 64 + s * 16 + fq * 4;
            const int cB_ = cu * 64 + (s + 2) * 16 + fq * 4;
            const Epi e = load_epi(gd);
            switch (ekind) {
                case EK_FFN1: small_epi<EK_FFN1>(e, row, cA_, v0, v1); break;
                case EK_CONVZ: small_epi<EK_CONVZ>(e, row, cA_, v0, v1); break;
                case EK_RES: small_epi<EK_RES>(e, row, cA_, v0, v0); small_epi<EK_RES>(e, row, cB_, v1, v1); break;
                case EK_GELU_UV: small_epi<EK_GELU_UV>(e, row, cA_, v0, v0); small_epi<EK_GELU_UV>(e, row, cB_, v1, v1); break;
                case EK_STORE: small_epi<EK_STORE>(e, row, cA_, v0, v0); small_epi<EK_STORE>(e, row, cB_, v1, v1); break;
                case EK_PLE: small_epi<EK_PLE>(e, row, cA_, v0, v0); small_epi<EK_PLE>(e, row, cB_, v1, v1); break;
                case EK_BIN: small_epi<EK_BIN>(e, row, cA_, v0, v0); small_epi<EK_BIN>(e, row, cB_, v1, v1); break;
                default: small_epi<EK_BL2>(e, row, cA_, v0, v0); small_epi<EK_BL2>(e, row, cB_, v1, v1); break;
            }
        }
        __syncthreads();
    }
}

__device__ __forceinline__ int srccol(int mode, int n0) {
    if (mode == 1) { const int pn = n0 >> 8, bj = (n0 >> 7) & 1, l = n0 & 127; return bj * DFF + pn * 128 + l; }
    if (mode == 2) { if (n0 < 2048) { const int pn = n0 >> 8, bj = (n0 >> 7) & 1, l = n0 & 127; return 1024 * (1 + bj) + pn * 128 + l; } return n0 - 2048; }
    return n0;
}
__device__ __forceinline__ void tconv(LAS float* tile, int& base, const float* src, int ld, int K, int ncols, bf16_t* dst, int ldd, int koff, int mode, const float* scale) {
    int tid_ = threadIdx.x; asm volatile("" : "+v"(tid_));
    const int nkt = K >> 6, ntl = nkt * (ncols >> 6), G = gridDim.x, tid = tid_;
    int t0 = ((int)blockIdx.x - (base % G) + G) % G; base += ntl;
    for (int t = t0; t < ntl; t += G) {
        const int kt = t % nkt, n0 = (t / nkt) * 64, k0 = kt * 64, sc0 = srccol(mode, n0);
        __syncthreads();
#pragma unroll
        for (int i = 0; i < 2; ++i) { const int kk = (tid >> 4) + i * 32, n4 = (tid & 15) * 4;
            f32x4 v = *(const f32x4*)(src + (size_t)(k0 + kk) * ld + sc0 + n4);
            if (scale) v = v * scale[k0 + kk];
#pragma unroll
            for (int j = 0; j < 4; ++j) tile[kk * 65 + n4 + j] = v[j]; }
        __syncthreads();
        { const int nn = tid >> 3, k8 = (tid & 7) * 8; u32x4 w;
            w.x = cvt_pk_bf16(tile[(k8 + 0) * 65 + nn], tile[(k8 + 1) * 65 + nn]); w.y = cvt_pk_bf16(tile[(k8 + 2) * 65 + nn], tile[(k8 + 3) * 65 + nn]);
            w.z = cvt_pk_bf16(tile[(k8 + 4) * 65 + nn], tile[(k8 + 5) * 65 + nn]); w.w = cvt_pk_bf16(tile[(k8 + 6) * 65 + nn], tile[(k8 + 7) * 65 + nn]);
            *(u32x4*)(dst + (size_t)(n0 + nn) * ldd + koff + k0 + k8) = w; }
    }
}
__device__ __forceinline__ void prep_phase(const Params& p, LAS unsigned char* lds) {
    const Ctx cx = mkctx(p);
    LAS float* tile = (LAS float*)lds; unsigned char* ws = cx.ws; int base = 0;
    const size_t gt = (size_t)blockIdx.x * 512 + cx.tid, gn = (size_t)gridDim.x * 512;
    for (int q = 0; q < 8; ++q) tconv(tile, base, p.in[9] + (size_t)q * 1024 * 5632, 5632, 1024, 5632, (bf16_t*)(ws + W_FFN_IN) + (size_t)q * 5632 * 1024, 1024, 0, 1, nullptr);
    for (int q = 0; q < 8; ++q) tconv(tile, base, p.in[10] + (size_t)q * 2816 * 1024, 1024, 2816, 1024, (bf16_t*)(ws + W_FFN_OUT) + (size_t)q * 1024 * 2816, 2816, 0, 0, nullptr);
    for (int i = 0; i < 4; ++i) tconv(tile, base, p.in[11] + (size_t)i * 1024 * 1024, 1024, 1024, 1024, (bf16_t*)(ws + W_PLE_G) + (size_t)i * 1024 * 1024, 1024, 0, 0, nullptr);
    for (int i = 0; i < 4; ++i) tconv(tile, base, p.in[12] + (size_t)i * 256 * 1024, 1024, 256, 1024, (bf16_t*)(ws + W_PLE_P) + (size_t)i * 1024 * 256, 256, 0, 0, nullptr);
    for (int j = 0; j < 2; ++j) tconv(tile, base, p.in[13] + (size_t)j * 1024 * 4096, 4096, 1024, 4096, (bf16_t*)(ws + W_A_IN) + (size_t)j * 4096 * 1024, 1024, 0, 0, nullptr);
    for (int j = 0; j < 2; ++j) tconv(tile, base, p.in[19] + (size_t)j * 2048 * 1024, 1024, 2048, 1024, (bf16_t*)(ws + W_A_OUT) + (size_t)j * 1024 * 2048, 2048, 0, 0, nullptr);
    bf16_t* bin = (bf16_t*)(ws + W_B_IN);
    for (int q = 0; q < 3; ++q) { const int mi = q == 0 ? 0 : (q == 1 ? 2 : 3);
        tconv(tile, base, p.in[21] + (size_t)q * 1024 * 1024, 1024, 1024, 1024, bin + (size_t)q * 1024 * 2048, 2048, 0, 0, nullptr);
        tconv(tile, base, p.in[21] + (size_t)q * 1024 * 1024, 1024, 1024, 1024, bin + (size_t)q * 1024 * 2048, 2048, 1024, 0, p.in[20] + mi * 1024); }
    tconv(tile, base, p.in[23], 64, 1024, 64, bin + (size_t)3072 * 2048, 2048, 0, 0, nullptr);
    tconv(tile, base, p.in[23], 64, 1024, 64, bin + (size_t)3072 * 2048, 2048, 1024, 0, p.in[20] + 1 * 1024);
    tconv(tile, base, p.in[26], 64, 1024, 64, bin + (size_t)3136 * 2048, 2048, 0, 0, nullptr);
    tconv(tile, base, p.in[26], 64, 1024, 64, bin + (size_t)3136 * 2048, 2048, 1024, 0, p.in[20] + 4 * 1024);
    tconv(tile, base, p.in[28], 128, 1024, 128, bin + (size_t)3200 * 2048, 2048, 0, 0, nullptr);
    tconv(tile, base, p.in[28], 128, 1024, 128, bin + (size_t)3200 * 2048, 2048, 1024, 0, p.in[20] + 5 * 1024);
    tconv(tile, base, p.in[35], 1024, 1024, 1024, (bf16_t*)(ws + W_B_O), 1024, 0, 0, nullptr);
    tconv(tile, base, p.in[36], 3072, 1024, 3072, (bf16_t*)(ws + W_C_IN), 1024, 0, 2, nullptr);
    tconv(tile, base, p.in[38], 1024, 1024, 1024, (bf16_t*)(ws + W_C_OUT), 1024, 0, 0, nullptr);
    { bf16_t* l2 = (bf16_t*)(ws + W_B_L2);
        for (size_t i = gt; i < (size_t)3072 * 256; i += gn) { const int n = (int)(i >> 8), k = (int)(i & 255); float v = 0.f;
            if (n < 1024) { if (k < 64) v = p.in[24][k * 1024 + n]; }
            else if (n < 2048) { if (k >= 64 && k < 128) v = p.in[27][(k - 64) * 1024 + (n - 1024)]; }
            else { if (k >= 128) v = p.in[29][(k - 128) * 1024 + (n - 2048)]; }
            l2[i] = (bf16_t)(cvt_pk_bf16(v, 0.f) & 0xffffu); } }
    { bf16_t* as = (bf16_t*)(ws + W_A_S);
        for (size_t i = gt; i < (size_t)2 * 8 * 128 * 128; i += gn) { const int s = (int)(i & 127), t = (int)((i >> 7) & 127); const float v = s <= t ? p.in[17][i] : 0.f; as[i] = (bf16_t)(cvt_pk_bf16(v, 0.f) & 0xffffu); } }
    { float* X = cx.out + O_Y; bf16_t* xb = (bf16_t*)(ws + A_XBALT);
        for (size_t i = gt; i < (size_t)MT * 256; i += gn) { const size_t e = i * 4; const f32x4 v = e < (size_t)MP * 1024 ? *(const f32x4*)(p.in[0] + e) : *(const f32x4*)(p.in[1] + (e - (size_t)MP * 1024));
            *(f32x4*)(X + e) = v; *(u32x2*)(xb + e) = f4_to_bf4(v); } }
}

__device__ __forceinline__ void ln_phase(const Params& p, int layer, int which, bool write_pb) {
    const Ctx cx = mkctx(p);
    const int lane = cx.tid & 63, gw = blockIdx.x * 8 + (cx.tid >> 6), nw = gridDim.x * 8;
    float* X = cx.out + O_Y; bf16_t* xb = (bf16_t*)(cx.ws + A_XB);
    const float* g = p.in[7] + (size_t)(layer * 3 + which) * 1024; const float* b = p.in[8] + (size_t)(layer * 3 + which) * 1024;
    f32x4 gv[4], bv[4];
#pragma unroll
    for (int i = 0; i < 4; ++i) { gv[i] = *(const f32x4*)(g + i * 256 + lane * 4); bv[i] = *(const f32x4*)(b + i * 256 + lane * 4); }
    for (int row = gw; row < MT; row += nw) {
        f32x4 v[4]; float s = 0.f;
#pragma unroll
        for (int i = 0; i < 4; ++i) { v[i] = *(const f32x4*)(X + (size_t)row * 1024 + i * 256 + lane * 4); s += (v[i][0] + v[i][1]) + (v[i][2] + v[i][3]); }
        const float mean = wave_sum(s) * (1.0f / 1024.0f); float q = 0.f;
#pragma unroll
        for (int i = 0; i < 4; ++i) { v[i] = v[i] - mean; q += (v[i][0] * v[i][0] + v[i][1] * v[i][1]) + (v[i][2] * v[i][2] + v[i][3] * v[i][3]); }
        const float rstd = rsqrtf(wave_sum(q) * (1.0f / 1024.0f) + 1e-5f);
#pragma unroll
        for (int i = 0; i < 4; ++i) { const f32x4 y = v[i] * rstd * gv[i] + bv[i]; *(f32x4*)(X + (size_t)row * 1024 + i * 256 + lane * 4) = y; *(u32x2*)(xb + (size_t)row * 1024 + i * 256 + lane * 4) = f4_to_bf4(y); }
    }
    if (write_pb) { bf16_t* pb = (bf16_t*)(cx.ws + A_PB); const size_t gt = (size_t)blockIdx.x * 512 + cx.tid, gn = (size_t)gridDim.x * 512;
        for (size_t i = gt; i < (size_t)MT * 64; i += gn) { const size_t e = i * 4; const f32x4 v = e < (size_t)MP * 256 ? *(const f32x4*)(p.in[5] + (size_t)layer * MP * 256 + e) : *(const f32x4*)(p.in[6] + (size_t)layer * MS * 256 + (e - (size_t)MP * 256));
            *(u32x2*)(pb + e) = f4_to_bf4(v); } }
}
__device__ __forceinline__ void shift_phase(const Params& p0) {
    const Ctx cx = mkctx(p0); Params p = p0; p.ws = cx.ws; p.out = cx.out;
    const int lane = cx.tid & 63, gw = blockIdx.x * 8 + (cx.tid >> 6), nw = gridDim.x * 8;
    const float* X = p.out + O_Y; bf16_t* xc = (bf16_t*)(p.ws + A_XCAT);
    for (int row = gw; row < MT; row += nw) {
        int b, t, T; const float* prevp; float* shout;
        if (row < MP) { b = row >> 11; t = row & 2047; T = 2048; prevp = nullptr; shout = p.out + O_SHP + (size_t)b * 1024; }
        else { const int r = row - MP; b = r >> 2; t = r & 3; T = 4; prevp = p.in[3] + (size_t)b * 1024; shout = p.out + O_SHS + (size_t)b * 1024; }
        if (t > 0) prevp = X + (size_t)(row - 1) * 1024;
#pragma unroll
        for (int i = 0; i < 4; ++i) { const int c = i * 256 + lane * 4; const f32x4 x = *(const f32x4*)(X + (size_t)row * 1024 + c);
            const f32x4 pv = prevp ? *(const f32x4*)(prevp + c) : (f32x4){0.f, 0.f, 0.f, 0.f};
            *(u32x2*)(xc + (size_t)row * 2048 + c) = f4_to_bf4(x); *(u32x2*)(xc + (size_t)row * 2048 + 1024 + c) = f4_to_bf4(pv - x);
            if (t == T - 1) *(f32x4*)(shout + c) = x; }
    }
}
__device__ __forceinline__ void lnv_phase(const Params& p0, int jA) {
    const Ctx cx = mkctx(p0); Params p = p0; p.ws = cx.ws; p.out = cx.out;
    const int lane = cx.tid & 63, gw = blockIdx.x * 8 + (cx.tid >> 6), nw = gridDim.x * 8;
    const float* V = (const float*)(p.ws + A_V); bf16_t* vn = (bf16_t*)(p.ws + A_VN);
    const float* g = p.in[15] + (size_t)jA * 2048; const float* b = p.in[16] + (size_t)jA * 2048;
    for (int row = gw; row < MP; row += nw) {
        f32x4 v[8]; float s = 0.f;
#pragma unroll
        for (int i = 0; i < 8; ++i) { v[i] = *(const f32x4*)(V + (size_t)row * 2048 + i * 256 + lane * 4); s += (v[i][0] + v[i][1]) + (v[i][2] + v[i][3]); }
        const float mean = wave_sum(s) * (1.0f / 2048.0f); float q = 0.f;
#pragma unroll
        for (int i = 0; i < 8; ++i) { v[i] = v[i] - mean; q += (v[i][0] * v[i][0] + v[i][1] * v[i][1]) + (v[i][2] * v[i][2] + v[i][3] * v[i][3]); }
        const float rstd = rsqrtf(wave_sum(q) * (1.0f / 2048.0f) + 1e-5f);
#pragma unroll
        for (int i = 0; i < 8; ++i) { const int c = i * 256 + lane * 4; const f32x4 y = v[i] * rstd * *(const f32x4*)(g + c) + *(const f32x4*)(b + c); *(u32x2*)(vn + (size_t)row * 2048 + c) = f4_to_bf4(y); }
    }
    const bf16_t* U = (const bf16_t*)(p.ws + A_U); bf16_t* yb = (bf16_t*)(p.ws + A_YB);
    const float* wsp = p.in[17] + (size_t)jA * 8 * 128 * 128; const float* bsp = p.in[18] + (size_t)jA * 8 * 128;
    for (int bb = nw - 1 - gw; bb < 128; bb += nw) {
        float mean[4], rstd[4];
#pragma unroll
        for (int t = 0; t < 4; ++t) { const int row = MP + bb * 4 + t; f32x4 v[8]; float s = 0.f;
#pragma unroll
            for (int i = 0; i < 8; ++i) { v[i] = *(const f32x4*)(V + (size_t)row * 2048 + i * 256 + lane * 4); s += (v[i][0] + v[i][1]) + (v[i][2] + v[i][3]); }
            mean[t] = wave_sum(s) * (1.0f / 2048.0f); float q = 0.f;
#pragma unroll
            for (int i = 0; i < 8; ++i) { v[i] = v[i] - mean[t]; q += (v[i][0] * v[i][0] + v[i][1] * v[i][1]) + (v[i][2] * v[i][2] + v[i][3] * v[i][3]); }
            rstd[t] = rsqrtf(wave_sum(q) * (1.0f / 2048.0f) + 1e-5f); }
        for (int i = 0; i < 8; ++i) { const int c = i * 256 + lane * 4, h = i;
            const f32x4 g4 = *(const f32x4*)(g + c), b4 = *(const f32x4*)(b + c); f32x4 n[4];
#pragma unroll
            for (int t = 0; t < 4; ++t) { const int row = MP + bb * 4 + t; n[t] = (*(const f32x4*)(V + (size_t)row * 2048 + c) - mean[t]) * rstd[t] * g4 + b4;
                *(f32x4*)(p.out + O_AV + ((size_t)jA * 512 + bb * 4 + t) * 2048 + c) = n[t]; }
#pragma unroll
            for (int t = 0; t < 4; ++t) { const int row = MP + bb * 4 + t; const float bs = bsp[h * 128 + t]; f32x4 mx = (f32x4){bs, bs, bs, bs};
#pragma unroll
                for (int s = 0; s <= t; ++s) mx += n[s] * wsp[(h * 128 + t) * 128 + s];
                const f32x4 u = bf4_to_f4(*(const u32x2*)(U + (size_t)row * 2048 + c)); *(u32x2*)(yb + (size_t)row * 2048 + c) = f4_to_bf4(u * mx); }
        }
    }
}
__device__ __forceinline__ void spatial_phase(const Params& p0, int jA, LAS unsigned char* lds) {
    const Ctx cx = mkctx(p0); Params p = p0; p.ws = cx.ws; p.out = cx.out;
    const int tid = cx.tid, wid = tid >> 6, lane = tid & 63, fr = lane & 15, fq = lane >> 4;
    const bf16_t* vn = (const bf16_t*)(p.ws + A_VN); const bf16_t* U = (const bf16_t*)(p.ws + A_U); bf16_t* yb = (bf16_t*)(p.ws + A_YB);
    const bf16_t* was = (const bf16_t*)(p.ws + W_A_S) + (size_t)jA * 8 * 128 * 128; const float* bsp = p.in[18] + (size_t)jA * 8 * 128;
    constexpr int RS = 516;
    for (int u = blockIdx.x; u < 1024; u += gridDim.x) {
        const int c = u >> 3, h = u & 7;
        __syncthreads();
        for (int i = tid; i < 128 * 32; i += 512) { const int s = i >> 5, c8 = (i & 31) * 8; const u32x4 w = *(const u32x4*)(vn + (size_t)(c * 128 + s) * 2048 + h * 256 + c8);
            LAS unsigned* d = (LAS unsigned*)(lds + s * RS + c8 * 2); d[0] = w.x; d[1] = w.y; d[2] = w.z; d[3] = w.w; }
        __syncthreads();
        bf16x8 vf[2][4];
#pragma unroll
        for (int n = 0; n < 2; ++n)
#pragma unroll
            for (int kb = 0; kb < 4; ++kb)
#pragma unroll
                for (int j = 0; j < 8; ++j) vf[n][kb][j] = (short)*(const LAS unsigned short*)(lds + (kb * 32 + fq * 8 + j) * RS + (wid * 32 + n * 16 + fr) * 2);
        for (int tb = 0; tb < 8; ++tb) {
            f32x4 acc[2]; acc[0] = (f32x4){0.f, 0.f, 0.f, 0.f}; acc[1] = acc[0];
            const bf16_t* wrow = was + (size_t)(h * 128 + tb * 16 + fr) * 128 + fq * 8;
#pragma unroll
            for (int kb = 0; kb < 4; ++kb) if (kb <= (tb >> 1)) { const bf16x8 wf = *(const bf16x8*)(wrow + kb * 32);
                acc[0] = __builtin_amdgcn_mfma_f32_16x16x32_bf16(vf[0][kb], wf, acc[0], 0, 0, 0); acc[1] = __builtin_amdgcn_mfma_f32_16x16x32_bf16(vf[1][kb], wf, acc[1], 0, 0, 0); }
            const int row = c * 128 + tb * 16 + fr; const float bs = bsp[h * 128 + tb * 16 + fr];
#pragma unroll
            for (int n = 0; n < 2; ++n) { const int col = h * 256 + wid * 32 + n * 16 + fq * 4; const f32x4 uu = bf4_to_f4(*(const u32x2*)(U + (size_t)row * 2048 + col));
                *(u32x2*)(yb + (size_t)row * 2048 + col) = f4_to_bf4(uu * (acc[n] + bs)); }
        }
    }
}
__device__ __forceinline__ void conv_phase(const Params& p0) {
    const Ctx cx = mkctx(p0); Params p = p0; p.ws = cx.ws; p.out = cx.out;
    const float* Z = (const float*)(p.ws + A_Z); const float* BG = (const float*)(p.ws + A_BG); bf16_t* yc = (bf16_t*)(p.ws + A_YC);
    const float* cw = p.in[37];
    const size_t gt = (size_t)blockIdx.x * 512 + cx.tid, gn = (size_t)gridDim.x * 512;
    for (size_t i = gt; i < (size_t)MT * 256; i += gn) {
        const int row = (int)(i >> 8), c = (int)(i & 255) * 4; int b, t, T; const float* buf; float* cvout;
        if (row < MP) { b = row >> 11; t = row & 2047; T = 2048; buf = nullptr; cvout = p.out + O_CVP + (size_t)b * 2048; }
        else { const int r = row - MP; b = r >> 2; t = r & 3; T = 4; buf = p.in[4] + (size_t)b * 2048; cvout = p.out + O_CVS + (size_t)b * 2048; }
        const f32x4 z0 = *(const f32x4*)(Z + (size_t)row * 1024 + c); const f32x4 zero = (f32x4){0.f, 0.f, 0.f, 0.f};
        const f32x4 z1 = t >= 1 ? *(const f32x4*)(Z + (size_t)(row - 1) * 1024 + c) : (buf ? *(const f32x4*)(buf + 1024 + c) : zero);
        const f32x4 z2 = t >= 2 ? *(const f32x4*)(Z + (size_t)(row - 2) * 1024 + c) : (buf ? *(const f32x4*)(buf + (size_t)t * 1024 + c) : zero);
        const f32x4 cv = *(const f32x4*)(cw + c) * z2 + *(const f32x4*)(cw + 1024 + c) * z1 + *(const f32x4*)(cw + 2048 + c) * z0;
        const f32x4 bg = *(const f32x4*)(BG + (size_t)row * 1024 + c);
        *(u32x2*)(yc + (size_t)row * 1024 + c) = f4_to_bf4(bg * cv);
        if (t >= T - 2) *(f32x4*)(cvout + (size_t)(t - (T - 2)) * 1024 + c) = z0;
    }
}
__device__ __forceinline__ void scan_unit(const Params& p0, LAS unsigned char* lds, int rowbase, int T, int h, const float* s0, float* sout) {
    constexpr int TC = 32, BUF = 6 * TC * 64 * 4 + 256;
    const Ctx cx = mkctx(p0); Params p = p0; p.ws = cx.ws; p.out = cx.out;
    const int tid = cx.tid, wid = tid >> 6, lane = tid & 63, ksg = lane & 15, rl = lane >> 4;
    const int row0 = wid * 8 + rl * 2;
    const float* R = (const float*)(p.ws + A_R); const float* Kp = R + (size_t)MT * 1024; const float* Vp = Kp + (size_t)MT * 1024; const float* DEC = (const float*)(p.ws + A_DEC);
    const bf16_t* AA = (const bf16_t*)(p.ws + A_AA); const bf16_t* GG = (const bf16_t*)(p.ws + A_GG); bf16_t* outp = (bf16_t*)(p.ws + A_OUTPRE);
    LAS float* Y = (LAS float*)(lds + 2 * BUF);
    const int st = tid >> 4, se = (tid & 15) * 4, hc = h * 64 + se;
    const f32x4 kk_w = *(const f32x4*)(p.in[30] + hc), ka_w = *(const f32x4*)(p.in[31] + hc), rk_w = *(const f32x4*)(p.in[32] + hc);
    const f32x4 lg = *(const f32x4*)(p.in[33] + hc), lb = *(const f32x4*)(p.in[34] + hc);
    f32x4 S0, S1;
    if (s0) { S0 = *(const f32x4*)(s0 + (size_t)row0 * 64 + ksg * 4); S1 = *(const f32x4*)(s0 + (size_t)(row0 + 1) * 64 + ksg * 4); }
    else { S0 = (f32x4){0.f, 0.f, 0.f, 0.f}; S1 = S0; }
    f32x4 gr, gk, gv, gd; u32x2 ga;
    const f32x4 zero = (f32x4){0.f, 0.f, 0.f, 0.f};
#define SCAN_LOAD(t0) do { const bool ok_ = (t0) + st < T; const size_t o_ = (size_t)(rowbase + (t0) + st) * 1024 + hc; \
        gr = ok_ ? *(const f32x4*)(R + o_) : zero; gk = ok_ ? *(const f32x4*)(Kp + o_) : zero; gv = ok_ ? *(const f32x4*)(Vp + o_) : zero; gd = ok_ ? *(const f32x4*)(DEC + o_) : zero; \
        ga = ok_ ? *(const u32x2*)(AA + o_) : (u32x2){0u, 0u}; } while (0)
#define SCAN_STORE(bufi) do { LAS float* B_ = (LAS float*)(lds + (bufi) * BUF); const f32x4 a_ = bf4_to_f4(ga); f32x4 kkv = gk * kk_w; \
        float ss_ = (kkv[0] * kkv[0] + kkv[1] * kkv[1]) + (kkv[2] * kkv[2] + kkv[3] * kkv[3]); ss_ = red16(ss_); \
        const float inv_ = 1.0f / fmaxf(sqrtf(ss_), 1e-12f); kkv = kkv * inv_; \
        const f32x4 km_ = gk * ((a_ - 1.0f) * ka_w + 1.0f); const f32x4 rb_ = gr * km_ * rk_w; float bs_ = (rb_[0] + rb_[1]) + (rb_[2] + rb_[3]); bs_ = red16(bs_); \
        const int o_ = st * 64 + se; *(LAS f32x4*)(B_ + o_) = gd; *(LAS f32x4*)(B_ + 2048 + o_) = kkv; *(LAS f32x4*)(B_ + 4096 + o_) = kkv * a_; \
        *(LAS f32x4*)(B_ + 6144 + o_) = km_; *(LAS f32x4*)(B_ + 8192 + o_) = gr; *(LAS f32x4*)(B_ + 10240 + o_) = gv; if ((tid & 15) == 0) B_[12288 + st] = bs_; } while (0)
    __syncthreads();
    SCAN_LOAD(0); SCAN_STORE(0);
    __syncthreads();
    const int nch = (T + TC - 1) / TC;
    for (int c = 0; c < nch; ++c) {
        const int t0 = c * TC; const int nst = (T - t0) < TC ? (T - t0) : TC;
        if (c + 1 < nch) SCAN_LOAD(t0 + TC);
        const LAS float* B = (const LAS float*)(lds + (c & 1) * BUF);
        for (int tt = 0; tt < nst; ++tt) {
            const f32x4 w = *(const LAS f32x4*)(B + tt * 64 + ksg * 4), kk = *(const LAS f32x4*)(B + 2048 + tt * 64 + ksg * 4), ka = *(const LAS f32x4*)(B + 4096 + tt * 64 + ksg * 4);
            const f32x4 km = *(const LAS f32x4*)(B + 6144 + tt * 64 + ksg * 4), rr = *(const LAS f32x4*)(B + 8192 + tt * 64 + ksg * 4);
            const f32x2 vv = *(const LAS f32x2*)(B + 10240 + tt * 64 + row0);
            float p0 = (S0[0] * kk[0] + S0[1] * kk[1]) + (S0[2] * kk[2] + S0[3] * kk[3]);
            float p1 = (S1[0] * kk[0] + S1[1] * kk[1]) + (S1[2] * kk[2] + S1[3] * kk[3]);
            p0 = red16(p0); p1 = red16(p1);
            S0 = S0 * w - ka * p0 + km * vv.x;
            S1 = S1 * w - ka * p1 + km * vv.y;
            float q0 = (S0[0] * rr[0] + S0[1] * rr[1]) + (S0[2] * rr[2] + S0[3] * rr[3]);
            float q1 = (S1[0] * rr[0] + S1[1] * rr[1]) + (S1[2] * rr[2] + S1[3] * rr[3]);
            q0 = red16(q0); q1 = red16(q1);
            if (ksg == 0) *(LAS f32x2*)(Y + tt * 64 + row0) = (f32x2){q0, q1};
        }
        __syncthreads();
        if (st < nst) {
            const f32x4 y = *(const LAS f32x4*)(Y + st * 64 + se); const f32x4 v4 = *(const LAS f32x4*)(B + 10240 + st * 64 + se); const float bs = B[12288 + st];
            float s = (y[0] + y[1]) + (y[2] + y[3]); s = red16(s); const float mean = s * (1.0f / 64.0f);
            const f32x4 d = y - mean; float q = (d[0] * d[0] + d[1] * d[1]) + (d[2] * d[2] + d[3] * d[3]); q = red16(q);
            const float rstd = rsqrtf(q * (1.0f / 64.0f) + 64e-5f);
            const size_t o = (size_t)(rowbase + t0 + st) * 1024 + hc;
            const f32x4 g4 = bf4_to_f4(*(const u32x2*)(GG + o));
            *(u32x2*)(outp + o) = f4_to_bf4((d * rstd * lg + lb + v4 * bs) * g4);
        } else { float s = 0.f; s = red16(s); s = red16(s); (void)s; }
        if (c + 1 < nch) SCAN_STORE((c + 1) & 1);
        __syncthreads();
    }
    *(f32x4*)(sout + (size_t)row0 * 64 + ksg * 4) = S0; *(f32x4*)(sout + (size_t)(row0 + 1) * 64 + ksg * 4) = S1;
#undef SCAN_LOAD
#undef SCAN_STORE
}
__device__ __forceinline__ void scan_phase(const Params& p, LAS unsigned char* lds) {
    const int G = gridDim.x, c = blockIdx.x;
    if (c < 128 || G <= 128) {
        for (int u = c; u < 128; u += G) { const int b = u >> 4, h = u & 15; scan_unit(p, lds, b * 2048, 2048, h, nullptr, p.out + O_WKVP + (size_t)u * 4096); }
    }
    const int ns = G > 128 ? G - 128 : G, cs = G > 128 ? c - 128 : c;
    if (cs >= 0) for (int u = cs; u < 2048; u += ns) { const int b = u >> 4, h = u & 15; scan_unit(p, lds, MP + b * 4, 4, h, p.in[2] + (size_t)u * 4096, p.out + O_WKVS + (size_t)u * 4096); }
}

enum { PT_PREP = 0, PT_GEMM, PT_LN, PT_SHIFT, PT_LNV, PT_SPATIAL, PT_CONV, PT_SCAN };
struct Phase { int type; int ng; int a0, a1, a2; GemmDesc g[2]; };

__device__ __forceinline__ GemmDesc mk(const void* A, int lda, const void* Bt, int ldb, int K, int N, int kind, float* f0, void* h0, void* h1, const float* c0, const float* c1, float scale, int ld) {
    GemmDesc g; g.A = (const bf16_t*)A; g.Bt = (const bf16_t*)Bt; g.lda = lda; g.ldb = ldb; g.K = K; g.nN = N / 256;
    g.e.kind = kind; g.e.f0 = f0; g.e.h0 = (bf16_t*)h0; g.e.h1 = (bf16_t*)h1; g.e.c0 = c0; g.e.c1 = c1; g.e.scale = scale; g.e.ld = ld; return g; }

__device__ __forceinline__ void build_phase(const Params& p, int ph, Phase& P) {
    unsigned char* ws = p.ws; float* X = p.out + O_Y;
    P.ng = 0; P.a0 = P.a1 = P.a2 = 0; P.type = PT_PREP;
    if (ph == 0) return;
    int q = ph - 1, layer, step;
    if (q < 12) { layer = 0; step = q; } else if (q < 25) { layer = 1; step = q - 12; } else if (q < 36) { layer = 2; step = q - 25; } else { layer = 3; step = q - 36; }
    const int kind = layer % 3, j = layer / 3;
    const int nmix = kind == 0 ? 4 : (kind == 1 ? 5 : 3);
    const bf16_t* ffn_in0 = (const bf16_t*)(ws + W_FFN_IN) + (size_t)(layer * 2) * 5632 * 1024;
    const bf16_t* ffn_out0 = (const bf16_t*)(ws + W_FFN_OUT) + (size_t)(layer * 2) * 1024 * 2816;
    if (step == 0) { P.type = PT_GEMM; P.ng = 1; P.g[0] = mk(ws + A_XBALT, 1024, ffn_in0, 1024, 1024, 5632, EK_FFN1, nullptr, ws + A_ACT, nullptr, nullptr, nullptr, 0.f, 0); return; }
    if (step == 1) { P.type = PT_GEMM; P.ng = 1; P.g[0] = mk(ws + A_ACT, DFF, ffn_out0, DFF, DFF, 1024, EK_RES, X, nullptr, nullptr, nullptr, nullptr, 0.5f, 0); return; }
    if (step == 2) { P.type = PT_LN; P.a0 = layer; P.a1 = 0; P.a2 = 0; return; }
    const int ms = step - 3;
    if (ms < nmix) {
        if (kind == 0) {
            if (ms == 0) { P.type = PT_GEMM; P.ng = 1; P.g[0] = mk(ws + A_XB, 1024, (const bf16_t*)(ws + W_A_IN) + (size_t)j * 4096 * 1024, 1024, 1024, 4096, EK_GELU_UV, (float*)(ws + A_V), ws + A_U, nullptr, p.in[14] + (size_t)j * 4096, nullptr, 0.f, 0); return; }
            if (ms == 1) { P.type = PT_LNV; P.a0 = j; return; }
            if (ms == 2) { P.type = PT_SPATIAL; P.a0 = j; return; }
            P.type = PT_GEMM; P.ng = 1; P.g[0] = mk(ws + A_YB, 2048, (const bf16_t*)(ws + W_A_OUT) + (size_t)j * 1024 * 2048, 2048, 2048, 1024, EK_RES, X, nullptr, nullptr, nullptr, nullptr, 1.0f, 0); return;
        } else if (kind == 1) {
            if (ms == 0) { P.type = PT_SHIFT; return; }
            if (ms == 1) { P.type = PT_GEMM; P.ng = 1; P.g[0] = mk(ws + A_XCAT, 2048, ws + W_B_IN, 2048, 2048, 3328, EK_BIN, (float*)(ws + A_R), ws + A_T, nullptr, nullptr, nullptr, 0.f, 0); return; }
            if (ms == 2) { P.type = PT_GEMM; P.ng = 1; P.g[0] = mk(ws + A_T, 256, ws + W_B_L2, 256, 256, 3072, EK_BL2, (float*)(ws + A_DEC), ws + A_AA, ws + A_GG, p.in[22], p.in[25], 0.f, 0); return; }
            if (ms == 3) { P.type = PT_SCAN; return; }
            P.type = PT_GEMM; P.ng = 1; P.g[0] = mk(ws + A_OUTPRE, 1024, ws + W_B_O, 1024, 1024, 1024, EK_RES, X, nullptr, nullptr, nullptr, nullptr, 1.0f, 0); return;
        } else {
            if (ms == 0) { P.type = PT_GEMM; P.ng = 2;
                P.g[0] = mk(ws + A_XB, 1024, ws + W_C_IN, 1024, 1024, 2048, EK_CONVZ, (float*)(ws + A_Z), nullptr, nullptr, nullptr, nullptr, 0.f, 0);
                P.g[1] = mk(ws + A_XB, 1024, (const bf16_t*)(ws + W_C_IN) + (size_t)2048 * 1024, 1024, 1024, 1024, EK_STORE, (float*)(ws + A_BG), nullptr, nullptr, nullptr, nullptr, 0.f, 1024); return; }
            if (ms == 1) { P.type = PT_CONV; return; }
            P.type = PT_GEMM; P.ng = 1; P.g[0] = mk(ws + A_YC, 1024, ws + W_C_OUT, 1024, 1024, 1024, EK_RES, X, nullptr, nullptr, nullptr, nullptr, 1.0f, 0); return;
        }
    }
    const int ts = ms - nmix;
    if (ts == 0) { P.type = PT_LN; P.a0 = layer; P.a1 = 1; P.a2 = 1; return; }
    if (ts == 1) { P.type = PT_GEMM; P.ng = 2;
        P.g[0] = mk(ws + A_XB, 1024, ffn_in0 + (size_t)5632 * 1024, 1024, 1024, 5632, EK_FFN1, nullptr, ws + A_ACT, nullptr, nullptr, nullptr, 0.f, 0);
        P.g[1] = mk(ws + A_PB, 256, (const bf16_t*)(ws + W_PLE_P) + (size_t)layer * 1024 * 256, 256, 256, 1024, EK_STORE, (float*)(ws + A_PP), nullptr, nullptr, nullptr, nullptr, 0.f, 1024); return; }
    if (ts == 2) { P.type = PT_GEMM; P.ng = 1; P.g[0] = mk(ws + A_ACT, DFF, ffn_out0 + (size_t)1024 * 2816, DFF, DFF, 1024, EK_RES, X, nullptr, nullptr, nullptr, nullptr, 0.5f, 0); return; }
    if (ts == 3) { P.type = PT_LN; P.a0 = layer; P.a1 = 2; P.a2 = 0; return; }
    P.type = PT_GEMM; P.ng = 1; P.g[0] = mk(ws + A_XB, 1024, (const bf16_t*)(ws + W_PLE_G) + (size_t)layer * 1024 * 1024, 1024, 1024, 1024, EK_PLE, X, ws + A_XBALT, nullptr, (const float*)(ws + A_PP), nullptr, 0.f, 0);
}
constexpr int NPHASES = 1 + 12 + 13 + 11 + 12;

__global__ void __launch_bounds__(512) fwd_megakernel(Params p) {
    extern __shared__ __attribute__((aligned(16))) unsigned char lds_raw[];
    LAS unsigned char* lds = (LAS unsigned char*)lds_raw;
    cg::grid_group grid = cg::this_grid();
    Phase* tab = (Phase*)(p.ws + A_TAB);
    if (blockIdx.x == 0 && threadIdx.x < NPHASES) build_phase(p, threadIdx.x, tab[threadIdx.x]);
    prep_phase(p, lds);
    grid.sync();
    for (int ph = 1; ph < NPHASES; ++ph) {
        const Phase* P = tab + ph;
        const int type = uload32(&P->type);
        switch (type) {
            case PT_GEMM: { const int ng = uload32(&P->ng); for (int gi = 0; gi < ng; ++gi) { const GemmDesc* g = &P->g[gi]; gemm_big(lds, g); gemm_small(lds, g); } } break;
            case PT_LN: ln_phase(p, uload32(&P->a0), uload32(&P->a1), uload32(&P->a2) != 0); break;
            case PT_SHIFT: shift_phase(p); break;
            case PT_LNV: lnv_phase(p, uload32(&P->a0)); break;
            case PT_SPATIAL: spatial_phase(p, uload32(&P->a0), lds); break;
            case PT_CONV: conv_phase(p); break;
            default: scan_phase(p, lds); break;
        }
        grid.sync();
    }
}

extern "C" void kernel_launch(void* const* d_in, const int* in_sizes, int n_in, void* d_out, int out_size, void* d_ws, size_t ws_size, hipStream_t stream) {
    static int grid_blocks = 0;
    if (grid_blocks == 0) {
        if (n_in != 39 || ws_size < WS_END) { fprintf(stderr, "kernel_launch: need 39 inputs and %zu bytes of workspace, got %d / %zu\n", (size_t)WS_END, n_in, ws_size); grid_blocks = -1; return; }
        int dev = 0, cus = 0, per_cu = 0;
        hipGetDevice(&dev); hipDeviceGetAttribute(&cus, hipDeviceAttributeMultiprocessorCount, dev);
        if (hipFuncSetAttribute((const void*)fwd_megakernel, hipFuncAttributeMaxDynamicSharedMemorySize, LDS_BYTES) != hipSuccess) { fprintf(stderr, "kernel_launch: hipFuncSetAttribute failed\n"); grid_blocks = -1; return; }
        hipOccupancyMaxActiveBlocksPerMultiprocessor(&per_cu, (const void*)fwd_megakernel, 512, LDS_BYTES);
        if (per_cu < 1) { fprintf(stderr, "kernel_launch: occupancy query says %d blocks per CU\n", per_cu); per_cu = 1; }
        (void)hipGetLastError();
        grid_blocks = cus;
    }
    if (grid_blocks < 0) return;
    Params p{};
    for (int i = 0; i < 39; ++i) p.in[i] = (const float*)d_in[i];
    p.out = (float*)d_out; p.ws = (unsigned char*)d_ws;
    void* args[] = {&p};
    hipError_t e = hipLaunchCooperativeKernel((const void*)fwd_megakernel, dim3(grid_blocks), dim3(512), args, LDS_BYTES, stream);
    if (e != hipSuccess) fprintf(stderr, "cooperative launch failed: %s (grid %d)\n", hipGetErrorString(e), grid_blocks);
}
```

```cpp
#include <hip/hip_runtime.h>
#include <hip/hip_cooperative_groups.h>
#include <cstdio>
namespace cg = cooperative_groups;

#define LAS __attribute__((address_space(3)))
#define GAS __attribute__((address_space(1)))
typedef unsigned short bf16_t;
typedef short bf16x8 __attribute__((ext_vector_type(8)));
typedef float f32x4 __attribute__((ext_vector_type(4)));
typedef float f32x2 __attribute__((ext_vector_type(2)));
typedef unsigned u32x4 __attribute__((ext_vector_type(4)));
typedef unsigned u32x2 __attribute__((ext_vector_type(2)));

constexpr int D = 1024, MP = 16384, MS = 512, MT = MP + MS, DFF = 2816;
constexpr float ALPHA = 1.6817928305074290f;
constexpr int BM = 256, BK = 64, HALF = 128, HTB = HALF * BK * 2, STAGE_BYTES = 8 * HTB, NXCD = 8, WGM = 8;
constexpr int LDS_BYTES = STAGE_BYTES;

constexpr size_t SZ_ROWF = (size_t)MT * 1024 * 4;
constexpr size_t W_FFN_IN = 0;
constexpr size_t W_FFN_OUT = W_FFN_IN + (size_t)8 * 5632 * 1024 * 2;
constexpr size_t W_PLE_G = W_FFN_OUT + (size_t)8 * 1024 * 2816 * 2;
constexpr size_t W_PLE_P = W_PLE_G + (size_t)4 * 1024 * 1024 * 2;
constexpr size_t W_A_IN = W_PLE_P + (size_t)4 * 1024 * 256 * 2;
constexpr size_t W_A_OUT = W_A_IN + (size_t)2 * 4096 * 1024 * 2;
constexpr size_t W_A_S = W_A_OUT + (size_t)2 * 1024 * 2048 * 2;
constexpr size_t W_B_IN = W_A_S + (size_t)2 * 8 * 128 * 128 * 2;
constexpr size_t W_B_L2 = W_B_IN + (size_t)3328 * 2048 * 2;
constexpr size_t W_B_O = W_B_L2 + (size_t)3072 * 256 * 2;
constexpr size_t W_C_IN = W_B_O + (size_t)1024 * 1024 * 2;
constexpr size_t W_C_OUT = W_C_IN + (size_t)3072 * 1024 * 2;
constexpr size_t A_XB = W_C_OUT + (size_t)1024 * 1024 * 2;
constexpr size_t A_ACT = A_XB + (size_t)MT * 1024 * 2;
constexpr size_t A_PB = A_ACT + (size_t)MT * 2816 * 2;
constexpr size_t A_PP = A_PB + (size_t)MT * 256 * 2;
constexpr size_t A_MIX = A_PP + SZ_ROWF;
constexpr size_t A_TAB = A_MIX + 4 * SZ_ROWF;
constexpr size_t WS_END = A_TAB + 65536;
constexpr size_t A_XBALT = A_MIX;
constexpr size_t A_U = A_MIX, A_V = A_MIX + (size_t)MT * 2048 * 2, A_VN = A_V + (size_t)MT * 2048 * 4, A_YB = A_ACT;
constexpr size_t A_R = A_MIX, A_DEC = A_MIX + 3 * SZ_ROWF, A_AA = A_ACT, A_GG = A_ACT + (size_t)MT * 1024 * 2, A_T = A_GG + (size_t)MT * 1024 * 2;
constexpr size_t A_XCAT = A_PP, A_OUTPRE = A_PP;
constexpr size_t A_Z = A_MIX, A_BG = A_MIX + SZ_ROWF, A_YC = A_ACT;
static_assert(A_VN + (size_t)MP * 2048 * 2 <= WS_END, "mix region");

constexpr size_t O_Y = 0, O_AV = (size_t)MT * 1024, O_WKVP = O_AV + (size_t)2 * 512 * 2048, O_SHP = O_WKVP + 524288, O_CVP = O_SHP + 8192,
                 O_WKVS = O_CVP + 16384, O_SHS = O_WKVS + 8388608, O_CVS = O_SHS + 131072;

struct Params { const float* in[39]; float* out; unsigned char* ws; };
struct Ctx { int tid; unsigned char* ws; float* out; };
__device__ __forceinline__ Ctx mkctx(const Params& p) { Ctx c; c.tid = threadIdx.x; size_t z = 0; asm volatile("" : "+v"(c.tid)); asm volatile("" : "+s"(z)); c.ws = p.ws + z; c.out = p.out + z; return c; }
__device__ __forceinline__ int uload32(const void* p) { return __builtin_amdgcn_readfirstlane(*(const volatile int*)p); }
template <class T> __device__ __forceinline__ T* uloadp(const void* p) { const unsigned lo = (unsigned)uload32(p), hi = (unsigned)uload32((const char*)p + 4); return (T*)(((unsigned long long)hi << 32) | lo); }

__device__ __forceinline__ unsigned cvt_pk_bf16(float lo, float hi) { unsigned r; asm("v_cvt_pk_bf16_f32 %0, %1, %2" : "=v"(r) : "v"(lo), "v"(hi)); return r; }
__device__ __forceinline__ float bf2f(unsigned short b) { return __uint_as_float(((unsigned)b) << 16); }
__device__ __forceinline__ f32x4 bf4_to_f4(u32x2 w) { return (f32x4){__uint_as_float(w.x << 16), __uint_as_float(w.x & 0xffff0000u), __uint_as_float(w.y << 16), __uint_as_float(w.y & 0xffff0000u)}; }
__device__ __forceinline__ u32x2 f4_to_bf4(f32x4 v) { u32x2 w; w.x = cvt_pk_bf16(v[0], v[1]); w.y = cvt_pk_bf16(v[2], v[3]); return w; }
__device__ __forceinline__ float wave_sum(float v) {
#pragma unroll
    for (int o = 32; o >= 1; o >>= 1) v += __shfl_xor(v, o);
    return v; }
template <int CTRL> __device__ __forceinline__ float dppmov(float v) { return __int_as_float(__builtin_amdgcn_update_dpp(0, __float_as_int(v), CTRL, 0xF, 0xF, true)); }
__device__ __forceinline__ float red16(float v) { v += dppmov<0xB1>(v); v += dppmov<0x4E>(v); v += dppmov<0x141>(v); v += dppmov<0x140>(v); return v; }
__device__ __forceinline__ float sigmoidf_(float x) { return 1.0f / (1.0f + __expf(-x)); }
__device__ __forceinline__ float tanh_(float x) { const float e = __expf(-2.0f * fabsf(x)); const float t = (1.0f - e) / (1.0f + e); return x < 0.f ? -t : t; }
__device__ __forceinline__ float decay_(float w) { const float sp = fmaxf(-w, 0.f) + __logf(1.0f + __expf(-fabsf(w))); return __expf(-__expf(-sp - 0.5f)); }
__device__ __forceinline__ f32x2 gelu_pk(f32x2 v) {
    const f32x2 av = __builtin_elementwise_abs(v), d = av * 0.2316418882f + 1.0f;
    f32x2 t; t.x = __builtin_amdgcn_rcpf(d.x); t.y = __builtin_amdgcn_rcpf(d.y);
    f32x2 q = t * 0.5307027145f + (-0.7265760135f); q = q * t + 0.7107068705f; q = q * t + (-0.142248368f); q = q * t + 0.127414796f; q = q * t;
    const f32x2 s = (v * v) * (-0.72134752044f);
    f32x2 e; e.x = __builtin_amdgcn_exp2f(s.x); e.y = __builtin_amdgcn_exp2f(s.y);
    const f32x2 m = v * (q * e), r = v - m;
    f32x2 o; o.x = v.x < 0.f ? m.x : r.x; o.y = v.y < 0.f ? m.y : r.y; return o;
}
__device__ __forceinline__ f32x4 gelu4(f32x4 v) { f32x2 a = gelu_pk((f32x2){v[0], v[1]}), b = gelu_pk((f32x2){v[2], v[3]}); return (f32x4){a.x, a.y, b.x, b.y}; }

enum { EK_FFN1 = 0, EK_RES, EK_GELU_UV, EK_STORE, EK_CONVZ, EK_PLE, EK_BIN, EK_BL2 };
struct Epi { int kind; float* f0; bf16_t* h0; bf16_t* h1; const float* c0; const float* c1; float scale; int ld; };
struct GemmDesc { const bf16_t* A; const bf16_t* Bt; int lda, ldb, K, nN; Epi e; };
struct EpiG { int kind; GAS float* f0; GAS bf16_t* h0; GAS bf16_t* h1; const GAS float* c0; const GAS float* c1; float scale; int ld; };
__device__ __forceinline__ EpiG load_epi(const GemmDesc* g) { EpiG e; e.kind = uload32(&g->e.kind); e.f0 = (GAS float*)uloadp<float>(&g->e.f0); e.h0 = (GAS bf16_t*)uloadp<bf16_t>(&g->e.h0); e.h1 = (GAS bf16_t*)uloadp<bf16_t>(&g->e.h1);
    e.c0 = (const GAS float*)uloadp<const float>(&g->e.c0); e.c1 = (const GAS float*)uloadp<const float>(&g->e.c1); e.scale = __int_as_float(uload32(&g->e.scale)); e.ld = uload32(&g->e.ld); return e; }

template <int KIND> __device__ __forceinline__ void epi_elem(const EpiG& e, int row, int col, f32x4 v0, f32x4 v1) {
    if (KIND == EK_FFN1) {
        f32x4 o;
#pragma unroll
        for (int j = 0; j < 4; ++j) o[j] = v0[j] * __builtin_amdgcn_rcpf(1.0f + __expf(-v0[j])) * v1[j];
        *(GAS u32x2*)(e.h0 + (size_t)row * DFF + col) = f4_to_bf4(o);
    } else if (KIND == EK_RES) {
        GAS float* p = e.f0 + (size_t)row * 1024 + col; const f32x4 x = *(const f32x4*)p; *(f32x4*)p = x * ALPHA + v0 * e.scale;
    } else if (KIND == EK_GELU_UV) {
        const f32x4 b = *(const GAS f32x4*)(e.c0 + col); const f32x4 g = gelu4(v0 + b);
        if (col < 2048) *(GAS u32x2*)(e.h0 + (size_t)row * 2048 + col) = f4_to_bf4(g);
        else *(GAS f32x4*)(e.f0 + (size_t)row * 2048 + (col - 2048)) = g;
    } else if (KIND == EK_STORE) {
        *(GAS f32x4*)(e.f0 + (size_t)row * e.ld + col) = v0;
    } else if (KIND == EK_CONVZ) {
        *(GAS f32x4*)(e.f0 + (size_t)row * 1024 + col) = v0 * v1;
    } else if (KIND == EK_PLE) {
        GAS float* p = e.f0 + (size_t)row * 1024 + col; f32x4 x = *(const f32x4*)p; const f32x4 pp = *(const GAS f32x4*)(e.c0 + (size_t)row * 1024 + col);
#pragma unroll
        for (int j = 0; j < 4; ++j) x[j] += pp[j] * __builtin_amdgcn_rcpf(1.0f + __expf(-v0[j]));
        *(f32x4*)p = x; *(GAS u32x2*)(e.h0 + (size_t)row * 1024 + col) = f4_to_bf4(x);
    } else if (KIND == EK_BIN) {
        if (col < 3072) { const int t = col >> 10; *(GAS f32x4*)(e.f0 + (size_t)t * ((size_t)MT * 1024) + (size_t)row * 1024 + (col & 1023)) = v0; }
        else { const int c = col - 3072; f32x4 o;
            if (c < 64) { o[0] = tanh_(v0[0]); o[1] = tanh_(v0[1]); o[2] = tanh_(v0[2]); o[3] = tanh_(v0[3]); }
            else if (c < 128) o = v0;
            else { o[0] = sigmoidf_(v0[0]); o[1] = sigmoidf_(v0[1]); o[2] = sigmoidf_(v0[2]); o[3] = sigmoidf_(v0[3]); }
            *(GAS u32x2*)(e.h0 + (size_t)row * 256 + c) = f4_to_bf4(o); }
    } else if (KIND == EK_BL2) {
        if (col < 1024) { const f32x4 w0 = *(const GAS f32x4*)(e.c0 + col); f32x4 o;
#pragma unroll
            for (int j = 0; j < 4; ++j) o[j] = decay_(w0[j] + v0[j]);
            *(GAS f32x4*)(e.f0 + (size_t)row * 1024 + col) = o;
        } else if (col < 2048) { const int c = col - 1024; const f32x4 a0 = *(const GAS f32x4*)(e.c1 + c); f32x4 o;
#pragma unroll
            for (int j = 0; j < 4; ++j) o[j] = sigmoidf_(a0[j] + v0[j]);
            *(GAS u32x2*)(e.h0 + (size_t)row * 1024 + c) = f4_to_bf4(o);
        } else { *(GAS u32x2*)(e.h1 + (size_t)row * 1024 + (col - 2048)) = f4_to_bf4(v0); }
    }
}
template <int KIND> __device__ __forceinline__ void epi_big(const GemmDesc* gd, const f32x4 (&acc)[2][2][4][2], int pm, int pn, int wr, int wc, int fr, int fq) {
    constexpr bool PAIRED = (KIND == EK_FFN1 || KIND == EK_CONVZ);
    const EpiG e = load_epi(gd);
#pragma unroll
    for (int ai = 0; ai < 2; ++ai)
#pragma unroll
        for (int m = 0; m < 4; ++m) {
            if (m & 1) asm volatile("" ::: "memory");
            const int row = pm * BM + ai * HALF + wr * 64 + m * 16 + fr;
#pragma unroll
            for (int n = 0; n < 2; ++n) {
                if (PAIRED) epi_elem<KIND>(e, row, pn * 128 + wc * 32 + n * 16 + fq * 4, acc[ai][0][m][n], acc[ai][1][m][n]);
                else {
#pragma unroll
                    for (int bj = 0; bj < 2; ++bj) epi_elem<KIND>(e, row, pn * BM + bj * HALF + wc * 32 + n * 16 + fq * 4, acc[ai][bj][m][n], acc[ai][bj][m][n]);
                }
            }
        }
}

__device__ __forceinline__ int lds_byte(int r, int c) { const int st = (r >> 4) * 2 + (c >> 5), rr = r & 15, cc = c & 31, ob = rr * 64 + cc * 2; return st * 1024 + (ob ^ (((ob >> 9) & 1) << 5)); }
__device__ __forceinline__ void stage_rc(int b, int& R, int& C) { const int st = b / 1024, sb = b % 1024, swz = sb ^ (((sb >> 9) & 1) << 5); R = (st >> 1) * 16 + swz / 64; C = (st & 1) * 32 + (swz % 64) / 2; }
struct Unit { int pm, pn; };
struct StaticOrder {
    int nM, nN, nwg, G, c;
    __device__ void init(int nM_, int nN_, int G_, int c_) { nM = nM_; nN = nN_; nwg = nM * nN; G = G_; c = c_; }
    __device__ bool next(int i, Unit& u) const {
        const long L = (long)i * G + c; if (L >= nwg) return false;
        int wgid = (int)L; { const int q = nwg / NXCD, r = nwg % NXCD, xcd = wgid % NXCD, off = wgid / NXCD; wgid = (xcd < r ? xcd * (q + 1) : r * (q + 1) + (xcd - r) * q) + off; }
        const int nig = WGM * nN, gid = wgid / nig, fm = gid * WGM, gsz = (nM - fm) < WGM ? (nM - fm) : WGM;
        u.pm = fm + ((wgid % nig) % gsz); u.pn = (wgid % nig) / gsz; return true;
    }
};

__device__ __forceinline__ void gemm_big(LAS unsigned char* lds, const GemmDesc* gd, const bool do_epi = true) {
    int tid_ = threadIdx.x; asm volatile("" : "+v"(tid_));
    const int tid = tid_, wid = __builtin_amdgcn_readfirstlane(tid >> 6), lane = tid & 63, wr = wid >> 2, wc = wid & 3, fr = lane & 15, fq = lane >> 4;
    struct { const bf16_t* A; const bf16_t* Bt; int lda, ldb, K, nN; } g;
    g.A = uloadp<const bf16_t>(&gd->A); g.Bt = uloadp<const bf16_t>(&gd->Bt); g.lda = uload32(&gd->lda); g.ldb = uload32(&gd->ldb); g.K = uload32(&gd->K); g.nN = uload32(&gd->nN);
    const int ekind = uload32(&gd->e.kind);
    const int K = g.K, nt = K / BK;
    StaticOrder S; S.init(MP / BM, g.nN, gridDim.x, blockIdx.x);
    unsigned voffA[2], voffB[2];
#pragma unroll
    for (int i = 0; i < 2; ++i) { int R, C; stage_rc(tid * 16 + i * 8192, R, C); voffA[i] = (unsigned)(R * g.lda + C) * 2u; voffB[i] = (unsigned)(R * g.ldb + C) * 2u; }
    const size_t kstep = (size_t)(BK * 2);
    const size_t hstepA = (size_t)HALF * g.lda * 2, hstepB = (size_t)HALF * g.ldb * 2;
    const size_t tstepA = 2 * hstepA, tstepB = 2 * hstepB;
    const unsigned ldsw = (unsigned)wid * 1024u;
    const int aoff = lds_byte(wr * 64 + fr, fq * 8), boff = lds_byte(wc * 32 + fr, fq * 8);
#define PG8_SA(b, h) (((b) * 2 + (h)) * HTB)
#define PG8_SB(b, h) ((4 + (b) * 2 + (h)) * HTB)
#define PG8_STAGE(bufoff, gbase, voff) do { _Pragma("unroll") for (int _i = 0; _i < 2; ++_i) \
        __builtin_amdgcn_global_load_lds((const unsigned*)((const char*)(gbase) + (voff)[_i]), (LAS unsigned*)(lds + (bufoff) + ldsw + _i * 8192), 16, 0, 0); } while (0)
#define PG8_LDA(dst, b, h) do { _Pragma("unroll") for (int m = 0; m < 4; ++m) _Pragma("unroll") for (int k = 0; k < 2; ++k) dst[m][k] = *(const LAS bf16x8*)(lds + PG8_SA(b, h) + aoff + m * 2048 + k * 1024); } while (0)
#define PG8_LDB(dst, b, h) do { _Pragma("unroll") for (int n = 0; n < 2; ++n) _Pragma("unroll") for (int k = 0; k < 2; ++k) dst[n][k] = *(const LAS bf16x8*)(lds + PG8_SB(b, h) + boff + n * 2048 + k * 1024); } while (0)
#define PG8_MMA(ai, bj, At, Bt) do { __builtin_amdgcn_s_setprio(1); _Pragma("unroll") for (int m = 0; m < 4; ++m) _Pragma("unroll") for (int n = 0; n < 2; ++n) _Pragma("unroll") for (int k = 0; k < 2; ++k) \
        acc[ai][bj][m][n] = __builtin_amdgcn_mfma_f32_16x16x32_bf16(Bt[n][k], At[m][k], acc[ai][bj][m][n], 0, 0, 0); __builtin_amdgcn_s_setprio(0); } while (0)
#define PG8_WAIT_V(n) asm volatile("s_waitcnt vmcnt(" #n ")" ::: "memory")
#define PG8_WAIT_L(n) asm volatile("s_waitcnt lgkmcnt(" #n ")" ::: "memory")
#define PG8_BAR __builtin_amdgcn_s_barrier()
#define PG8_SCHED __builtin_amdgcn_sched_barrier(0)
    Unit cur, nxt; int ui = 0;
    if (!S.next(0, cur)) return;
    f32x4 acc[2][2][4][2];
#pragma unroll
    for (int a = 0; a < 2; ++a)
#pragma unroll
        for (int b = 0; b < 2; ++b)
#pragma unroll
            for (int m = 0; m < 4; ++m)
#pragma unroll
                for (int n = 0; n < 2; ++n) acc[a][b][m][n] = (f32x4){0.f, 0.f, 0.f, 0.f};
    bf16x8 At[4][2], B0[2][2], B1[2][2];
    const char* cA = (const char*)g.A + (size_t)cur.pm * tstepA; const char* cB = (const char*)g.Bt + (size_t)cur.pn * tstepB;
    PG8_STAGE(PG8_SB(0, 0), cB, voffB); PG8_STAGE(PG8_SA(0, 0), cA, voffA); PG8_STAGE(PG8_SB(0, 1), cB + hstepB, voffB); PG8_STAGE(PG8_SA(0, 1), cA + hstepA, voffA);
    if (wr == 1) PG8_BAR;
    PG8_WAIT_V(4); PG8_BAR;
    PG8_STAGE(PG8_SB(1, 0), cB + kstep, voffB); PG8_STAGE(PG8_SA(1, 0), cA + kstep, voffA); PG8_STAGE(PG8_SB(1, 1), cB + hstepB + kstep, voffB);
    PG8_WAIT_V(6); PG8_BAR;
    for (;;) {
        const bool has_next = S.next(ui + 1, nxt);
        const char* nA = has_next ? (const char*)g.A + (size_t)nxt.pm * tstepA : cA; const char* nB = has_next ? (const char*)g.Bt + (size_t)nxt.pn * tstepB : cB;
        for (int t = 0; t < nt; t += 2) {
            const bool last = (t == nt - 2);
            const char* a1 = cA + (size_t)(t + 1) * kstep;
            const char* a2 = last ? nA : cA + (size_t)(t + 2) * kstep; const char* b2 = last ? nB : cB + (size_t)(t + 2) * kstep;
            const char* a3 = a2 + kstep; const char* b3 = b2 + kstep;
            PG8_LDB(B0, 0, 0); PG8_SCHED; PG8_LDA(At, 0, 0); PG8_STAGE(PG8_SA(1, 1), a1 + hstepA, voffA);
            PG8_WAIT_L(8); PG8_BAR; PG8_WAIT_L(0); PG8_MMA(0, 0, At, B0); PG8_BAR; PG8_SCHED;
            PG8_LDB(B1, 0, 1); PG8_STAGE(PG8_SB(0, 0), b2, voffB);
            PG8_BAR; PG8_WAIT_L(0); PG8_MMA(0, 1, At, B1); PG8_BAR;
            PG8_LDA(At, 0, 1); PG8_STAGE(PG8_SA(0, 0), a2, voffA);
            PG8_BAR; PG8_WAIT_L(0); PG8_MMA(1, 0, At, B0); PG8_BAR; PG8_SCHED;
            PG8_STAGE(PG8_SB(0, 1), b2 + hstepB, voffB);
            PG8_WAIT_V(6); PG8_BAR; PG8_MMA(1, 1, At, B1); PG8_BAR;
            PG8_LDB(B0, 1, 0); PG8_SCHED; PG8_LDA(At, 1, 0); PG8_STAGE(PG8_SA(0, 1), a2 + hstepA, voffA);
            PG8_WAIT_L(8); PG8_BAR; PG8_WAIT_L(0); PG8_MMA(0, 0, At, B0); PG8_BAR; PG8_SCHED;
            PG8_LDB(B1, 1, 1); PG8_STAGE(PG8_SB(1, 0), b3, voffB);
            PG8_BAR; PG8_WAIT_L(0); PG8_MMA(0, 1, At, B1); PG8_BAR;
            PG8_LDA(At, 1, 1); PG8_STAGE(PG8_SA(1, 0), a3, voffA);
            PG8_BAR; PG8_WAIT_L(0); PG8_MMA(1, 0, At, B0); PG8_BAR; PG8_SCHED;
            PG8_STAGE(PG8_SB(1, 1), b3 + hstepB, voffB);
            PG8_WAIT_V(6); PG8_BAR; PG8_MMA(1, 1, At, B1); PG8_BAR;
        }
        if (do_epi) switch (ekind) {
            case EK_FFN1: epi_big<EK_FFN1>(gd, acc, cur.pm, cur.pn, wr, wc, fr, fq); break;
            case EK_RES: epi_big<EK_RES>(gd, acc, cur.pm, cur.pn, wr, wc, fr, fq); break;
            case EK_GELU_UV: epi_big<EK_GELU_UV>(gd, acc, cur.pm, cur.pn, wr, wc, fr, fq); break;
            case EK_STORE: epi_big<EK_STORE>(gd, acc, cur.pm, cur.pn, wr, wc, fr, fq); break;
            case EK_CONVZ: epi_big<EK_CONVZ>(gd, acc, cur.pm, cur.pn, wr, wc, fr, fq); break;
            case EK_PLE: epi_big<EK_PLE>(gd, acc, cur.pm, cur.pn, wr, wc, fr, fq); break;
            case EK_BIN: epi_big<EK_BIN>(gd, acc, cur.pm, cur.pn, wr, wc, fr, fq); break;
            default: epi_big<EK_BL2>(gd, acc, cur.pm, cur.pn, wr, wc, fr, fq); break;
        }
        if (!has_next) break;
#pragma unroll
        for (int a = 0; a < 2; ++a)
#pragma unroll
            for (int b = 0; b < 2; ++b)
#pragma unroll
                for (int m = 0; m < 4; ++m)
#pragma unroll
                    for (int n = 0; n < 2; ++n) acc[a][b][m][n] = (f32x4){0.f, 0.f, 0.f, 0.f};
        cur = nxt; cA = nA; cB = nB; ++ui;
    }
    PG8_WAIT_V(0);
    if (wr == 0) PG8_BAR;
    PG8_BAR;
#undef PG8_SA
#undef PG8_SB
#undef PG8_STAGE
#undef PG8_LDA
#undef PG8_LDB
#undef PG8_MMA
#undef PG8_WAIT_V
#undef PG8_WAIT_L
#undef PG8_BAR
#undef PG8_SCHED
}

template <int KIND> __device__ __forceinline__ void small_epi(const EpiG& e, int row, int col, f32x4 v0, f32x4 v1) { epi_elem<KIND>(e, row, col, v0, v1); }
__device__ __forceinline__ void gemm_small(LAS unsigned char* lds, const GemmDesc* gd) {
    int tid_ = threadIdx.x; asm volatile("" : "+v"(tid_));
    const int tid = tid_, wid = __builtin_amdgcn_readfirstlane(tid >> 6), lane = tid & 63, fr = lane & 15, fq = lane >> 4;
    struct { const GAS bf16_t* A; const GAS bf16_t* Bt; int lda, ldb, K, nN; } g;
    g.A = (const GAS bf16_t*)uloadp<const bf16_t>(&gd->A); g.Bt = (const GAS bf16_t*)uloadp<const bf16_t>(&gd->Bt); g.lda = uload32(&gd->lda); g.ldb = uload32(&gd->ldb); g.K = uload32(&gd->K); g.nN = uload32(&gd->nN);
    const int ekind = uload32(&gd->e.kind);
    const bool paired = (ekind == EK_FFN1 || ekind == EK_CONVZ);
    const int ncu = paired ? g.nN * 4 : g.nN * 4;
    const int nunits = 8 * ncu;
    const int kq = wid >> 1, nh = wid & 1;
    const int ks = g.K >> 2;
    LAS f32x4* P = (LAS f32x4*)lds;
    for (int su = (int)(gridDim.x - 1 - blockIdx.x); su < nunits; su += gridDim.x) {
        const int rp = su & 7, cu = su >> 3;
        const int row0 = MP + rp * 64;
        int brow[2];
#pragma unroll
        for (int j = 0; j < 2; ++j) { const int nb = nh * 2 + j;
            if (paired) { const int p0 = cu * 32; brow[j] = (p0 >> 7) * 256 + (nb >> 1) * 128 + (p0 & 127) + (nb & 1) * 16 + fr; }
            else brow[j] = cu * 64 + nb * 16 + fr; }
        const GAS bf16_t* ap = g.A + (size_t)(row0 + fr) * g.lda + kq * ks + fq * 8;
        const GAS bf16_t* bp0 = g.Bt + (size_t)brow[0] * g.ldb + kq * ks + fq * 8;
        const GAS bf16_t* bp1 = g.Bt + (size_t)brow[1] * g.ldb + kq * ks + fq * 8;
        f32x4 acc[4][2];
#pragma unroll
        for (int m = 0; m < 4; ++m) { acc[m][0] = (f32x4){0.f, 0.f, 0.f, 0.f}; acc[m][1] = (f32x4){0.f, 0.f, 0.f, 0.f}; }
#pragma unroll 2
        for (int k = 0; k < ks; k += 32) {
            bf16x8 a[4], b[2];
#pragma unroll
            for (int m = 0; m < 4; ++m) a[m] = *(const GAS bf16x8*)(ap + (size_t)(m * 16) * g.lda + k);
            b[0] = *(const GAS bf16x8*)(bp0 + k); b[1] = *(const GAS bf16x8*)(bp1 + k);
#pragma unroll
            for (int m = 0; m < 4; ++m) { acc[m][0] = __builtin_amdgcn_mfma_f32_16x16x32_bf16(b[0], a[m], acc[m][0], 0, 0, 0); acc[m][1] = __builtin_amdgcn_mfma_f32_16x16x32_bf16(b[1], a[m], acc[m][1], 0, 0, 0); }
        }
#pragma unroll
        for (int m = 0; m < 4; ++m)
#pragma unroll
            for (int j = 0; j < 2; ++j) P[((kq * 4 + m) * 4 + nh * 2 + j) * 64 + lane] = acc[m][j];
        __syncthreads();
        {   const int m = wid >> 1, s = wid & 1;
            f32x4 v0 = (f32x4){0.f, 0.f, 0.f, 0.f}, v1 = v0;
#pragma unroll
            for (int q = 0; q < 4; ++q) { v0 += P[((q * 4 + m) * 4 + s) * 64 + lane]; v1 += P[((q * 4 + m) * 4 + s + 2) * 64 + lane]; }
            const int row = row0 + m * 16 + fr;
            const int cA_ = paired ? cu * 32 + s * 16 + fq * 4 : cu * 64 + s * 16 + fq * 4;
            const int cB_ = cu * 64 + (s + 2) * 16 + fq * 4;
            const EpiG e = load_epi(gd);
            switch (ekind) {
                case EK_FFN1: small_epi<EK_FFN1>(e, row, cA_, v0, v1); break;
                case EK_CONVZ: small_epi<EK_CONVZ>(e, row, cA_, v0, v1); break;
                case EK_RES: small_epi<EK_RES>(e, row, cA_, v0, v0); small_epi<EK_RES>(e, row, cB_, v1, v1); break;
                case EK_GELU_UV: small_epi<EK_GELU_UV>(e, row, cA_, v0, v0); small_epi<EK_GELU_UV>(e, row, cB_, v1, v1); break;
                case EK_STORE: small_epi<EK_STORE>(e, row, cA_, v0, v0); small_epi<EK_STORE>(e, row, cB_, v1, v1); break;
                case EK_PLE: small_epi<EK_PLE>(e, row, cA_, v0, v0); small_epi<EK_PLE>(e, row, cB_, v1, v1); break;
                case EK_BIN: small_epi<EK_BIN>(e, row, cA_, v0, v0); small_epi<EK_BIN>(e, row, cB_, v1, v1); break;
                default: small_epi<EK_BL2>(e, row, cA_, v0, v0); small_epi<EK_BL2>(e, row, cB_, v1, v1); break;
            }
        }
        __syncthreads();
    }
}

__device__ __forceinline__ int srccol(int mode, int n0) {
    if (mode == 1) { const int pn = n0 >> 8, bj = (n0 >> 7) & 1, l = n0 & 127; return bj * DFF + pn * 128 + l; }
    if (mode == 2) { if (n0 < 2048) { const int pn = n0 >> 8, bj = (n0 >> 7) & 1, l = n0 & 127; return 1024 * (1 + bj) + pn * 128 + l; } return n0 - 2048; }
    return n0;
}
__device__ __forceinline__ void tconv(LAS float* tile, int& base, const float* src, int ld, int K, int ncols, bf16_t* dst, int ldd, int koff, int mode, const float* scale) {
    int tid_ = threadIdx.x; asm volatile("" : "+v"(tid_));
    const int nkt = K >> 6, ntl = nkt * (ncols >> 6), G = gridDim.x, tid = tid_;
    int t0 = ((int)blockIdx.x - (base % G) + G) % G; base += ntl;
    for (int t = t0; t < ntl; t += G) {
        const int kt = t % nkt, n0 = (t / nkt) * 64, k0 = kt * 64, sc0 = srccol(mode, n0);
        __syncthreads();
#pragma unroll
        for (int i = 0; i < 2; ++i) { const int kk = (tid >> 4) + i * 32, n4 = (tid & 15) * 4;
            f32x4 v = *(const f32x4*)(src + (size_t)(k0 + kk) * ld + sc0 + n4);
            if (scale) v = v * scale[k0 + kk];
#pragma unroll
            for (int j = 0; j < 4; ++j) tile[kk * 65 + n4 + j] = v[j]; }
        __syncthreads();
        { const int nn = tid >> 3, k8 = (tid & 7) * 8; u32x4 w;
            w.x = cvt_pk_bf16(tile[(k8 + 0) * 65 + nn], tile[(k8 + 1) * 65 + nn]); w.y = cvt_pk_bf16(tile[(k8 + 2) * 65 + nn], tile[(k8 + 3) * 65 + nn]);
            w.z = cvt_pk_bf16(tile[(k8 + 4) * 65 + nn], tile[(k8 + 5) * 65 + nn]); w.w = cvt_pk_bf16(tile[(k8 + 6) * 65 + nn], tile[(k8 + 7) * 65 + nn]);
            *(u32x4*)(dst + (size_t)(n0 + nn) * ldd + koff + k0 + k8) = w; }
    }
}
__device__ __forceinline__ void prep_phase(const Params& p, LAS unsigned char* lds) {
    const Ctx cx = mkctx(p);
    LAS float* tile = (LAS float*)lds; unsigned char* ws = cx.ws; int base = 0;
    const size_t gt = (size_t)blockIdx.x * 512 + cx.tid, gn = (size_t)gridDim.x * 512;
    for (int q = 0; q < 8; ++q) tconv(tile, base, p.in[9] + (size_t)q * 1024 * 5632, 5632, 1024, 5632, (bf16_t*)(ws + W_FFN_IN) + (size_t)q * 5632 * 1024, 1024, 0, 1, nullptr);
    for (int q = 0; q < 8; ++q) tconv(tile, base, p.in[10] + (size_t)q * 2816 * 1024, 1024, 2816, 1024, (bf16_t*)(ws + W_FFN_OUT) + (size_t)q * 1024 * 2816, 2816, 0, 0, nullptr);
    for (int i = 0; i < 4; ++i) tconv(tile, base, p.in[11] + (size_t)i * 1024 * 1024, 1024, 1024, 1024, (bf16_t*)(ws + W_PLE_G) + (size_t)i * 1024 * 1024, 1024, 0, 0, nullptr);
    for (int i = 0; i < 4; ++i) tconv(tile, base, p.in[12] + (size_t)i * 256 * 1024, 1024, 256, 1024, (bf16_t*)(ws + W_PLE_P) + (size_t)i * 1024 * 256, 256, 0, 0, nullptr);
    for (int j = 0; j < 2; ++j) tconv(tile, base, p.in[13] + (size_t)j * 1024 * 4096, 4096, 1024, 4096, (bf16_t*)(ws + W_A_IN) + (size_t)j * 4096 * 1024, 1024, 0, 0, nullptr);
    for (int j = 0; j < 2; ++j) tconv(tile, base, p.in[19] + (size_t)j * 2048 * 1024, 1024, 2048, 1024, (bf16_t*)(ws + W_A_OUT) + (size_t)j * 1024 * 2048, 2048, 0, 0, nullptr);
    bf16_t* bin = (bf16_t*)(ws + W_B_IN);
    for (int q = 0; q < 3; ++q) { const int mi = q == 0 ? 0 : (q == 1 ? 2 : 3);
        tconv(tile, base, p.in[21] + (size_t)q * 1024 * 1024, 1024, 1024, 1024, bin + (size_t)q * 1024 * 2048, 2048, 0, 0, nullptr);
        tconv(tile, base, p.in[21] + (size_t)q * 1024 * 1024, 1024, 1024, 1024, bin + (size_t)q * 1024 * 2048, 2048, 1024, 0, p.in[20] + mi * 1024); }
    tconv(tile, base, p.in[23], 64, 1024, 64, bin + (size_t)3072 * 2048, 2048, 0, 0, nullptr);
    tconv(tile, base, p.in[23], 64, 1024, 64, bin + (size_t)3072 * 2048, 2048, 1024, 0, p.in[20] + 1 * 1024);
    tconv(tile, base, p.in[26], 64, 1024, 64, bin + (size_t)3136 * 2048, 2048, 0, 0, nullptr);
    tconv(tile, base, p.in[26], 64, 1024, 64, bin + (size_t)3136 * 2048, 2048, 1024, 0, p.in[20] + 4 * 1024);
    tconv(tile, base, p.in[28], 128, 1024, 128, bin + (size_t)3200 * 2048, 2048, 0, 0, nullptr);
    tconv(tile, base, p.in[28], 128, 1024, 128, bin + (size_t)3200 * 2048, 2048, 1024, 0, p.in[20] + 5 * 1024);
    tconv(tile, base, p.in[35], 1024, 1024, 1024, (bf16_t*)(ws + W_B_O), 1024, 0, 0, nullptr);
    tconv(tile, base, p.in[36], 3072, 1024, 3072, (bf16_t*)(ws + W_C_IN), 1024, 0, 2, nullptr);
    tconv(tile, base, p.in[38], 1024, 1024, 1024, (bf16_t*)(ws + W_C_OUT), 1024, 0, 0, nullptr);
    { bf16_t* l2 = (bf16_t*)(ws + W_B_L2);
        for (size_t i = gt; i < (size_t)3072 * 256; i += gn) { const int n = (int)(i >> 8), k = (int)(i & 255); float v = 0.f;
            if (n < 1024) { if (k < 64) v = p.in[24][k * 1024 + n]; }
            else if (n < 2048) { if (k >= 64 && k < 128) v = p.in[27][(k - 64) * 1024 + (n - 1024)]; }
            else { if (k >= 128) v = p.in[29][(k - 128) * 1024 + (n - 2048)]; }
            l2[i] = (bf16_t)(cvt_pk_bf16(v, 0.f) & 0xffffu); } }
    { bf16_t* as = (bf16_t*)(ws + W_A_S);
        for (size_t i = gt; i < (size_t)2 * 8 * 128 * 128; i += gn) { const int s = (int)(i & 127), t = (int)((i >> 7) & 127); const float v = s <= t ? p.in[17][i] : 0.f; as[i] = (bf16_t)(cvt_pk_bf16(v, 0.f) & 0xffffu); } }
    { float* X = cx.out + O_Y; bf16_t* xb = (bf16_t*)(ws + A_XBALT);
        for (size_t i = gt; i < (size_t)MT * 256; i += gn) { const size_t e = i * 4; const f32x4 v = e < (size_t)MP * 1024 ? *(const f32x4*)(p.in[0] + e) : *(const f32x4*)(p.in[1] + (e - (size_t)MP * 1024));
            *(f32x4*)(X + e) = v; *(u32x2*)(xb + e) = f4_to_bf4(v); } }
}

__device__ __forceinline__ void ln_phase(const Params& p, int layer, int which, bool write_pb) {
    const Ctx cx = mkctx(p);
    const int lane = cx.tid & 63, gw = blockIdx.x * 8 + (cx.tid >> 6), nw = gridDim.x * 8;
    float* X = cx.out + O_Y; bf16_t* xb = (bf16_t*)(cx.ws + A_XB);
    const float* g = p.in[7] + (size_t)(layer * 3 + which) * 1024; const float* b = p.in[8] + (size_t)(layer * 3 + which) * 1024;
    f32x4 gv[4], bv[4];
#pragma unroll
    for (int i = 0; i < 4; ++i) { gv[i] = *(const f32x4*)(g + i * 256 + lane * 4); bv[i] = *(const f32x4*)(b + i * 256 + lane * 4); }
    for (int row = gw; row < MT; row += nw) {
        f32x4 v[4]; float s = 0.f;
#pragma unroll
        for (int i = 0; i < 4; ++i) { v[i] = *(const f32x4*)(X + (size_t)row * 1024 + i * 256 + lane * 4); s += (v[i][0] + v[i][1]) + (v[i][2] + v[i][3]); }
        const float mean = wave_sum(s) * (1.0f / 1024.0f); float q = 0.f;
#pragma unroll
        for (int i = 0; i < 4; ++i) { v[i] = v[i] - mean; q += (v[i][0] * v[i][0] + v[i][1] * v[i][1]) + (v[i][2] * v[i][2] + v[i][3] * v[i][3]); }
        const float rstd = rsqrtf(wave_sum(q) * (1.0f / 1024.0f) + 1e-5f);
#pragma unroll
        for (int i = 0; i < 4; ++i) { const f32x4 y = v[i] * rstd * gv[i] + bv[i]; *(f32x4*)(X + (size_t)row * 1024 + i * 256 + lane * 4) = y; *(u32x2*)(xb + (size_t)row * 1024 + i * 256 + lane * 4) = f4_to_bf4(y); }
    }
    if (write_pb) { bf16_t* pb = (bf16_t*)(cx.ws + A_PB); const size_t gt = (size_t)blockIdx.x * 512 + cx.tid, gn = (size_t)gridDim.x * 512;
        for (size_t i = gt; i < (size_t)MT * 64; i += gn) { const size_t e = i * 4; const f32x4 v = e < (size_t)MP * 256 ? *(const f32x4*)(p.in[5] + (size_t)layer * MP * 256 + e) : *(const f32x4*)(p.in[6] + (size_t)layer * MS * 256 + (e - (size_t)MP * 256));
            *(u32x2*)(pb + e) = f4_to_bf4(v); } }
}
__device__ __forceinline__ void shift_phase(const Params& p0) {
    const Ctx cx = mkctx(p0); Params p = p0; p.ws = cx.ws; p.out = cx.out;
    const int lane = cx.tid & 63, gw = blockIdx.x * 8 + (cx.tid >> 6), nw = gridDim.x * 8;
    const float* X = p.out + O_Y; bf16_t* xc = (bf16_t*)(p.ws + A_XCAT);
    for (int row = gw; row < MT; row += nw) {
        int b, t, T; const float* prevp; float* shout;
        if (row < MP) { b = row >> 11; t = row & 2047; T = 2048; prevp = nullptr; shout = p.out + O_SHP + (size_t)b * 1024; }
        else { const int r = row - MP; b = r >> 2; t = r & 3; T = 4; prevp = p.in[3] + (size_t)b * 1024; shout = p.out + O_SHS + (size_t)b * 1024; }
        if (t > 0) prevp = X + (size_t)(row - 1) * 1024;
#pragma unroll
        for (int i = 0; i < 4; ++i) { const int c = i * 256 + lane * 4; const f32x4 x = *(const f32x4*)(X + (size_t)row * 1024 + c);
            const f32x4 pv = prevp ? *(const f32x4*)(prevp + c) : (f32x4){0.f, 0.f, 0.f, 0.f};
            *(u32x2*)(xc + (size_t)row * 2048 + c) = f4_to_bf4(x); *(u32x2*)(xc + (size_t)row * 2048 + 1024 + c) = f4_to_bf4(pv - x);
            if (t == T - 1) *(f32x4*)(shout + c) = x; }
    }
}
__device__ __forceinline__ void lnv_phase(const Params& p0, int jA) {
    const Ctx cx = mkctx(p0); Params p = p0; p.ws = cx.ws; p.out = cx.out;
    const int lane = cx.tid & 63, gw = blockIdx.x * 8 + (cx.tid >> 6), nw = gridDim.x * 8;
    const float* V = (const float*)(p.ws + A_V); bf16_t* vn = (bf16_t*)(p.ws + A_VN);
    const float* g = p.in[15] + (size_t)jA * 2048; const float* b = p.in[16] + (size_t)jA * 2048;
    for (int row = gw; row < MP; row += nw) {
        f32x4 v[8]; float s = 0.f;
#pragma unroll
        for (int i = 0; i < 8; ++i) { v[i] = *(const f32x4*)(V + (size_t)row * 2048 + i * 256 + lane * 4); s += (v[i][0] + v[i][1]) + (v[i][2] + v[i][3]); }
        const float mean = wave_sum(s) * (1.0f / 2048.0f); float q = 0.f;
#pragma unroll
        for (int i = 0; i < 8; ++i) { v[i] = v[i] - mean; q += (v[i][0] * v[i][0] + v[i][1] * v[i][1]) + (v[i][2] * v[i][2] + v[i][3] * v[i][3]); }
        const float rstd = rsqrtf(wave_sum(q) * (1.0f / 2048.0f) + 1e-5f);
#pragma unroll
        for (int i = 0; i < 8; ++i) { const int c = i * 256 + lane * 4; const f32x4 y = v[i] * rstd * *(const f32x4*)(g + c) + *(const f32x4*)(b + c); *(u32x2*)(vn + (size_t)row * 2048 + c) = f4_to_bf4(y); }
    }
    const bf16_t* U = (const bf16_t*)(p.ws + A_U); bf16_t* yb = (bf16_t*)(p.ws + A_YB);
    const float* wsp = p.in[17] + (size_t)jA * 8 * 128 * 128; const float* bsp = p.in[18] + (size_t)jA * 8 * 128;
    for (int bb = nw - 1 - gw; bb < 128; bb += nw) {
        float mean[4], rstd[4];
#pragma unroll
        for (int t = 0; t < 4; ++t) { const int row = MP + bb * 4 + t; f32x4 v[8]; float s = 0.f;
#pragma unroll
            for (int i = 0; i < 8; ++i) { v[i] = *(const f32x4*)(V + (size_t)row * 2048 + i * 256 + lane * 4); s += (v[i][0] + v[i][1]) + (v[i][2] + v[i][3]); }
            mean[t] = wave_sum(s) * (1.0f / 2048.0f); float q = 0.f;
#pragma unroll
            for (int i = 0; i < 8; ++i) { v[i] = v[i] - mean[t]; q += (v[i][0] * v[i][0] + v[i][1] * v[i][1]) + (v[i][2] * v[i][2] + v[i][3] * v[i][3]); }
            rstd[t] = rsqrtf(wave_sum(q) * (1.0f / 2048.0f) + 1e-5f); }
        for (int i = 0; i < 8; ++i) { const int c = i * 256 + lane * 4, h = i;
            const f32x4 g4 = *(const f32x4*)(g + c), b4 = *(const f32x4*)(b + c); f32x4 n[4];
#pragma unroll
            for (int t = 0; t < 4; ++t) { const int row = MP + bb * 4 + t; n[t] = (*(const f32x4*)(V + (size_t)row * 2048 + c) - mean[t]) * rstd[t] * g4 + b4;
                *(f32x4*)(p.out + O_AV + ((size_t)jA * 512 + bb * 4 + t) * 2048 + c) = n[t]; }
#pragma unroll
            for (int t = 0; t < 4; ++t) { const int row = MP + bb * 4 + t; const float bs = bsp[h * 128 + t]; f32x4 mx = (f32x4){bs, bs, bs, bs};
#pragma unroll
                for (int s = 0; s <= t; ++s) mx += n[s] * wsp[(h * 128 + t) * 128 + s];
                const f32x4 u = bf4_to_f4(*(const u32x2*)(U + (size_t)row * 2048 + c)); *(u32x2*)(yb + (size_t)row * 2048 + c) = f4_to_bf4(u * mx); }
        }
    }
}
__device__ __forceinline__ void spatial_phase(const Params& p0, int jA, LAS unsigned char* lds) {
    const Ctx cx = mkctx(p0); Params p = p0; p.ws = cx.ws; p.out = cx.out;
    const int tid = cx.tid, wid = tid >> 6, lane = tid & 63, fr = lane & 15, fq = lane >> 4;
    const bf16_t* vn = (const bf16_t*)(p.ws + A_VN); const bf16_t* U = (const bf16_t*)(p.ws + A_U); bf16_t* yb = (bf16_t*)(p.ws + A_YB);
    const bf16_t* was = (const bf16_t*)(p.ws + W_A_S) + (size_t)jA * 8 * 128 * 128; const float* bsp = p.in[18] + (size_t)jA * 8 * 128;
    constexpr int RS = 516;
    for (int u = blockIdx.x; u < 1024; u += gridDim.x) {
        const int c = u >> 3, h = u & 7;
        __syncthreads();
        for (int i = tid; i < 128 * 32; i += 512) { const int s = i >> 5, c8 = (i & 31) * 8; const u32x4 w = *(const u32x4*)(vn + (size_t)(c * 128 + s) * 2048 + h * 256 + c8);
            LAS unsigned* d = (LAS unsigned*)(lds + s * RS + c8 * 2); d[0] = w.x; d[1] = w.y; d[2] = w.z; d[3] = w.w; }
        __syncthreads();
        bf16x8 vf[2][4];
#pragma unroll
        for (int n = 0; n < 2; ++n)
#pragma unroll
            for (int kb = 0; kb < 4; ++kb)
#pragma unroll
                for (int j = 0; j < 8; ++j) vf[n][kb][j] = (short)*(const LAS unsigned short*)(lds + (kb * 32 + fq * 8 + j) * RS + (wid * 32 + n * 16 + fr) * 2);
        for (int tb = 0; tb < 8; ++tb) {
            f32x4 acc[2]; acc[0] = (f32x4){0.f, 0.f, 0.f, 0.f}; acc[1] = acc[0];
            const bf16_t* wrow = was + (size_t)(h * 128 + tb * 16 + fr) * 128 + fq * 8;
#pragma unroll
            for (int kb = 0; kb < 4; ++kb) if (kb <= (tb >> 1)) { const bf16x8 wf = *(const bf16x8*)(wrow + kb * 32);
                acc[0] = __builtin_amdgcn_mfma_f32_16x16x32_bf16(vf[0][kb], wf, acc[0], 0, 0, 0); acc[1] = __builtin_amdgcn_mfma_f32_16x16x32_bf16(vf[1][kb], wf, acc[1], 0, 0, 0); }
            const int row = c * 128 + tb * 16 + fr; const float bs = bsp[h * 128 + tb * 16 + fr];
#pragma unroll
            for (int n = 0; n < 2; ++n) { const int col = h * 256 + wid * 32 + n * 16 + fq * 4; const f32x4 uu = bf4_to_f4(*(const u32x2*)(U + (size_t)row * 2048 + col));
                *(u32x2*)(yb + (size_t)row * 2048 + col) = f4_to_bf4(uu * (acc[n] + bs)); }
        }
    }
}
__device__ __forceinline__ void conv_phase(const Params& p0) {
    const Ctx cx = mkctx(p0); Params p = p0; p.ws = cx.ws; p.out = cx.out;
    const float* Z = (const float*)(p.ws + A_Z); const float* BG = (const float*)(p.ws + A_BG); bf16_t* yc = (bf16_t*)(p.ws + A_YC);
    const float* cw = p.in[37];
    const size_t gt = (size_t)blockIdx.x * 512 + cx.tid, gn = (size_t)gridDim.x * 512;
    for (size_t i = gt; i < (size_t)MT * 256; i += gn) {
        const int row = (int)(i >> 8), c = (int)(i & 255) * 4; int b, t, T; const float* buf; float* cvout;
        if (row < MP) { b = row >> 11; t = row & 2047; T = 2048; buf = nullptr; cvout = p.out + O_CVP + (size_t)b * 2048; }
        else { const int r = row - MP; b = r >> 2; t = r & 3; T = 4; buf = p.in[4] + (size_t)b * 2048; cvout = p.out + O_CVS + (size_t)b * 2048; }
        const f32x4 z0 = *(const f32x4*)(Z + (size_t)row * 1024 + c); const f32x4 zero = (f32x4){0.f, 0.f, 0.f, 0.f};
        const f32x4 z1 = t >= 1 ? *(const f32x4*)(Z + (size_t)(row - 1) * 1024 + c) : (buf ? *(const f32x4*)(buf + 1024 + c) : zero);
        const f32x4 z2 = t >= 2 ? *(const f32x4*)(Z + (size_t)(row - 2) * 1024 + c) : (buf ? *(const f32x4*)(buf + (size_t)t * 1024 + c) : zero);
        const f32x4 cv = *(const f32x4*)(cw + c) * z2 + *(const f32x4*)(cw + 1024 + c) * z1 + *(const f32x4*)(cw + 2048 + c) * z0;
        const f32x4 bg = *(const f32x4*)(BG + (size_t)row * 1024 + c);
        *(u32x2*)(yc + (size_t)row * 1024 + c) = f4_to_bf4(bg * cv);
        if (t >= T - 2) *(f32x4*)(cvout + (size_t)(t - (T - 2)) * 1024 + c) = z0;
    }
}
__device__ __forceinline__ void scan_unit(const Params& p0, LAS unsigned char* lds, int rowbase, int T, int h, const float* s0, float* sout) {
    constexpr int TC = 32, BUF = 6 * TC * 64 * 4 + 256;
    const Ctx cx = mkctx(p0); Params p = p0; p.ws = cx.ws; p.out = cx.out;
    const int tid = cx.tid, wid = tid >> 6, lane = tid & 63, ksg = lane & 15, rl = lane >> 4;
    const int row0 = wid * 8 + rl * 2;
    const float* R = (const float*)(p.ws + A_R); const float* Kp = R + (size_t)MT * 1024; const float* Vp = Kp + (size_t)MT * 1024; const float* DEC = (const float*)(p.ws + A_DEC);
    const bf16_t* AA = (const bf16_t*)(p.ws + A_AA); const bf16_t* GG = (const bf16_t*)(p.ws + A_GG); bf16_t* outp = (bf16_t*)(p.ws + A_OUTPRE);
    LAS float* Y = (LAS float*)(lds + 2 * BUF);
    const int st = tid >> 4, se = (tid & 15) * 4, hc = h * 64 + se;
    const f32x4 kk_w = *(const f32x4*)(p.in[30] + hc), ka_w = *(const f32x4*)(p.in[31] + hc), rk_w = *(const f32x4*)(p.in[32] + hc);
    const f32x4 lg = *(const f32x4*)(p.in[33] + hc), lb = *(const f32x4*)(p.in[34] + hc);
    f32x4 S0, S1;
    if (s0) { S0 = *(const f32x4*)(s0 + (size_t)row0 * 64 + ksg * 4); S1 = *(const f32x4*)(s0 + (size_t)(row0 + 1) * 64 + ksg * 4); }
    else { S0 = (f32x4){0.f, 0.f, 0.f, 0.f}; S1 = S0; }
    f32x4 gr, gk, gv, gd; u32x2 ga;
    const f32x4 zero = (f32x4){0.f, 0.f, 0.f, 0.f};
#define SCAN_LOAD(t0) do { const bool ok_ = (t0) + st < T; const size_t o_ = (size_t)(rowbase + (t0) + st) * 1024 + hc; \
        gr = ok_ ? *(const f32x4*)(R + o_) : zero; gk = ok_ ? *(const f32x4*)(Kp + o_) : zero; gv = ok_ ? *(const f32x4*)(Vp + o_) : zero; gd = ok_ ? *(const f32x4*)(DEC + o_) : zero; \
        ga = ok_ ? *(const u32x2*)(AA + o_) : (u32x2){0u, 0u}; } while (0)
#define SCAN_STORE(bufi) do { LAS float* B_ = (LAS float*)(lds + (bufi) * BUF); const f32x4 a_ = bf4_to_f4(ga); f32x4 kkv = gk * kk_w; \
        float ss_ = (kkv[0] * kkv[0] + kkv[1] * kkv[1]) + (kkv[2] * kkv[2] + kkv[3] * kkv[3]); ss_ = red16(ss_); \
        const float inv_ = 1.0f / fmaxf(sqrtf(ss_), 1e-12f); kkv = kkv * inv_; \
        const f32x4 km_ = gk * ((a_ - 1.0f) * ka_w + 1.0f); const f32x4 rb_ = gr * km_ * rk_w; float bs_ = (rb_[0] + rb_[1]) + (rb_[2] + rb_[3]); bs_ = red16(bs_); \
        const int o_ = st * 64 + se; *(LAS f32x4*)(B_ + o_) = gd; *(LAS f32x4*)(B_ + 2048 + o_) = kkv; *(LAS f32x4*)(B_ + 4096 + o_) = kkv * a_; \
        *(LAS f32x4*)(B_ + 6144 + o_) = km_; *(LAS f32x4*)(B_ + 8192 + o_) = gr; *(LAS f32x4*)(B_ + 10240 + o_) = gv; if ((tid & 15) == 0) B_[12288 + st] = bs_; } while (0)
    __syncthreads();
    SCAN_LOAD(0); SCAN_STORE(0);
    __syncthreads();
    const int nch = (T + TC - 1) / TC;
    for (int c = 0; c < nch; ++c) {
        const int t0 = c * TC; const int nst = (T - t0) < TC ? (T - t0) : TC;
        if (c + 1 < nch) SCAN_LOAD(t0 + TC);
        const LAS float* B = (const LAS float*)(lds + (c & 1) * BUF);
        for (int tt = 0; tt < nst; ++tt) {
            const f32x4 w = *(const LAS f32x4*)(B + tt * 64 + ksg * 4), kk = *(const LAS f32x4*)(B + 2048 + tt * 64 + ksg * 4), ka = *(const LAS f32x4*)(B + 4096 + tt * 64 + ksg * 4);
            const f32x4 km = *(const LAS f32x4*)(B + 6144 + tt * 64 + ksg * 4), rr = *(const LAS f32x4*)(B + 8192 + tt * 64 + ksg * 4);
            const f32x2 vv = *(const LAS f32x2*)(B + 10240 + tt * 64 + row0);
            float p0 = (S0[0] * kk[0] + S0[1] * kk[1]) + (S0[2] * kk[2] + S0[3] * kk[3]);
            float p1 = (S1[0] * kk[0] + S1[1] * kk[1]) + (S1[2] * kk[2] + S1[3] * kk[3]);
            p0 = red16(p0); p1 = red16(p1);
            S0 = S0 * w - ka * p0 + km * vv.x;
            S1 = S1 * w - ka * p1 + km * vv.y;
            float q0 = (S0[0] * rr[0] + S0[1] * rr[1]) + (S0[2] * rr[2] + S0[3] * rr[3]);
            float q1 = (S1[0] * rr[0] + S1[1] * rr[1]) + (S1[2] * rr[2] + S1[3] * rr[3]);
            q0 = red16(q0); q1 = red16(q1);
            if (ksg == 0) *(LAS f32x2*)(Y + tt * 64 + row0) = (f32x2){q0, q1};
        }
        __syncthreads();
        if (st < nst) {
            const f32x4 y = *(const LAS f32x4*)(Y + st * 64 + se); const f32x4 v4 = *(const LAS f32x4*)(B + 10240 + st * 64 + se); const float bs = B[12288 + st];
            float s = (y[0] + y[1]) + (y[2] + y[3]); s = red16(s); const float mean = s * (1.0f / 64.0f);
            const f32x4 d = y - mean; float q = (d[0] * d[0] + d[1] * d[1]) + (d[2] * d[2] + d[3] * d[3]); q = red16(q);
            const float rstd = rsqrtf(q * (1.0f / 64.0f) + 64e-5f);
            const size_t o = (size_t)(rowbase + t0 + st) * 1024 + hc;
            const f32x4 g4 = bf4_to_f4(*(const u32x2*)(GG + o));
            *(u32x2*)(outp + o) = f4_to_bf4((d * rstd * lg + lb + v4 * bs) * g4);
        } else { float s = 0.f; s = red16(s); s = red16(s); (void)s; }
        if (c + 1 < nch) SCAN_STORE((c + 1) & 1);
        __syncthreads();
    }
    *(f32x4*)(sout + (size_t)row0 * 64 + ksg * 4) = S0; *(f32x4*)(sout + (size_t)(row0 + 1) * 64 + ksg * 4) = S1;
#undef SCAN_LOAD
#undef SCAN_STORE
}
__device__ __forceinline__ void scan_phase(const Params& p, LAS unsigned char* lds) {
    const int G = gridDim.x, c = blockIdx.x;
    if (c < 128 || G <= 128) {
        for (int u = c; u < 128; u += G) { const int b = u >> 4, h = u & 15; scan_unit(p, lds, b * 2048, 2048, h, nullptr, p.out + O_WKVP + (size_t)u * 4096); }
    }
    const int ns = G > 128 ? G - 128 : G, cs = G > 128 ? c - 128 : c;
    if (cs >= 0) for (int u = cs; u < 2048; u += ns) { const int b = u >> 4, h = u & 15; scan_unit(p, lds, MP + b * 4, 4, h, p.in[2] + (size_t)u * 4096, p.out + O_WKVS + (size_t)u * 4096); }
}

enum { PT_PREP = 0, PT_GEMM, PT_LN, PT_SHIFT, PT_LNV, PT_SPATIAL, PT_CONV, PT_SCAN };
struct Phase { int type; int ng; int a0, a1, a2; GemmDesc g[2]; };

__device__ __forceinline__ GemmDesc mk(const void* A, int lda, const void* Bt, int ldb, int K, int N, int kind, float* f0, void* h0, void* h1, const float* c0, const float* c1, float scale, int ld) {
    GemmDesc g; g.A = (const bf16_t*)A; g.Bt = (const bf16_t*)Bt; g.lda = lda; g.ldb = ldb; g.K = K; g.nN = N / 256;
    g.e.kind = kind; g.e.f0 = f0; g.e.h0 = (bf16_t*)h0; g.e.h1 = (bf16_t*)h1; g.e.c0 = c0; g.e.c1 = c1; g.e.scale = scale; g.e.ld = ld; return g; }

__device__ __forceinline__ void build_phase(const Params& p, int ph, Phase& P) {
    unsigned char* ws = p.ws; float* X = p.out + O_Y;
    P.ng = 0; P.a0 = P.a1 = P.a2 = 0; P.type = PT_PREP;
    if (ph == 0) return;
    int q = ph - 1, layer, step;
    if (q < 12) { layer = 0; step = q; } else if (q < 25) { layer = 1; step = q - 12; } else if (q < 36) { layer = 2; step = q - 25; } else { layer = 3; step = q - 36; }
    const int kind = layer % 3, j = layer / 3;
    const int nmix = kind == 0 ? 4 : (kind == 1 ? 5 : 3);
    const bf16_t* ffn_in0 = (const bf16_t*)(ws + W_FFN_IN) + (size_t)(layer * 2) * 5632 * 1024;
    const bf16_t* ffn_out0 = (const bf16_t*)(ws + W_FFN_OUT) + (size_t)(layer * 2) * 1024 * 2816;
    if (step == 0) { P.type = PT_GEMM; P.ng = 1; P.g[0] = mk(ws + A_XBALT, 1024, ffn_in0, 1024, 1024, 5632, EK_FFN1, nullptr, ws + A_ACT, nullptr, nullptr, nullptr, 0.f, 0); return; }
    if (step == 1) { P.type = PT_GEMM; P.ng = 1; P.g[0] = mk(ws + A_ACT, DFF, ffn_out0, DFF, DFF, 1024, EK_RES, X, nullptr, nullptr, nullptr, nullptr, 0.5f, 0); return; }
    if (step == 2) { P.type = PT_LN; P.a0 = layer; P.a1 = 0; P.a2 = 0; return; }
    const int ms = step - 3;
    if (ms < nmix) {
        if (kind == 0) {
            if (ms == 0) { P.type = PT_GEMM; P.ng = 1; P.g[0] = mk(ws + A_XB, 1024, (const bf16_t*)(ws + W_A_IN) + (size_t)j * 4096 * 1024, 1024, 1024, 4096, EK_GELU_UV, (float*)(ws + A_V), ws + A_U, nullptr, p.in[14] + (size_t)j * 4096, nullptr, 0.f, 0); return; }
            if (ms == 1) { P.type = PT_LNV; P.a0 = j; return; }
            if (ms == 2) { P.type = PT_SPATIAL; P.a0 = j; return; }
            P.type = PT_GEMM; P.ng = 1; P.g[0] = mk(ws + A_YB, 2048, (const bf16_t*)(ws + W_A_OUT) + (size_t)j * 1024 * 2048, 2048, 2048, 1024, EK_RES, X, nullptr, nullptr, nullptr, nullptr, 1.0f, 0); return;
        } else if (kind == 1) {
            if (ms == 0) { P.type = PT_SHIFT; return; }
            if (ms == 1) { P.type = PT_GEMM; P.ng = 1; P.g[0] = mk(ws + A_XCAT, 2048, ws + W_B_IN, 2048, 2048, 3328, EK_BIN, (float*)(ws + A_R), ws + A_T, nullptr, nullptr, nullptr, 0.f, 0); return; }
            if (ms == 2) { P.type = PT_GEMM; P.ng = 1; P.g[0] = mk(ws + A_T, 256, ws + W_B_L2, 256, 256, 3072, EK_BL2, (float*)(ws + A_DEC), ws + A_AA, ws + A_GG, p.in[22], p.in[25], 0.f, 0); return; }
            if (ms == 3) { P.type = PT_SCAN; return; }
            P.type = PT_GEMM; P.ng = 1; P.g[0] = mk(ws + A_OUTPRE, 1024, ws + W_B_O, 1024, 1024, 1024, EK_RES, X, nullptr, nullptr, nullptr, nullptr, 1.0f, 0); return;
        } else {
            if (ms == 0) { P.type = PT_GEMM; P.ng = 2;
                P.g[0] = mk(ws + A_XB, 1024, ws + W_C_IN, 1024, 1024, 2048, EK_CONVZ, (float*)(ws + A_Z), nullptr, nullptr, nullptr, nullptr, 0.f, 0);
                P.g[1] = mk(ws + A_XB, 1024, (const bf16_t*)(ws + W_C_IN) + (size_t)2048 * 1024, 1024, 1024, 1024, EK_STORE, (float*)(ws + A_BG), nullptr, nullptr, nullptr, nullptr, 0.f, 1024); return; }
            if (ms == 1) { P.type = PT_CONV; return; }
            P.type = PT_GEMM; P.ng = 1; P.g[0] = mk(ws + A_YC, 1024, ws + W_C_OUT, 1024, 1024, 1024, EK_RES, X, nullptr, nullptr, nullptr, nullptr, 1.0f, 0); return;
        }
    }
    const int ts = ms - nmix;
    if (ts == 0) { P.type = PT_LN; P.a0 = layer; P.a1 = 1; P.a2 = 1; return; }
    if (ts == 1) { P.type = PT_GEMM; P.ng = 2;
        P.g[0] = mk(ws + A_XB, 1024, ffn_in0 + (size_t)5632 * 1024, 1024, 1024, 5632, EK_FFN1, nullptr, ws + A_ACT, nullptr, nullptr, nullptr, 0.f, 0);
        P.g[1] = mk(ws + A_PB, 256, (const bf16_t*)(ws + W_PLE_P) + (size_t)layer * 1024 * 256, 256, 256, 1024, EK_STORE, (float*)(ws + A_PP), nullptr, nullptr, nullptr, nullptr, 0.f, 1024); return; }
    if (ts == 2) { P.type = PT_GEMM; P.ng = 1; P.g[0] = mk(ws + A_ACT, DFF, ffn_out0 + (size_t)1024 * 2816, DFF, DFF, 1024, EK_RES, X, nullptr, nullptr, nullptr, nullptr, 0.5f, 0); return; }
    if (ts == 3) { P.type = PT_LN; P.a0 = layer; P.a1 = 2; P.a2 = 0; return; }
    P.type = PT_GEMM; P.ng = 1; P.g[0] = mk(ws + A_XB, 1024, (const bf16_t*)(ws + W_PLE_G) + (size_t)layer * 1024 * 1024, 1024, 1024, 1024, EK_PLE, X, ws + A_XBALT, nullptr, (const float*)(ws + A_PP), nullptr, 0.f, 0);
}
constexpr int NPHASES = 1 + 12 + 13 + 11 + 12;
#ifndef PROBE_MASK
#define PROBE_MASK 0
#endif

__global__ void __launch_bounds__(512) fwd_megakernel(Params p) {
    extern __shared__ __attribute__((aligned(16))) unsigned char lds_raw[];
    LAS unsigned char* lds = (LAS unsigned char*)lds_raw;
    cg::grid_group grid = cg::this_grid();
    Phase* tab = (Phase*)(p.ws + A_TAB);
    if (blockIdx.x == 0 && threadIdx.x < NPHASES) build_phase(p, threadIdx.x, tab[threadIdx.x]);
    for (int rep = 0; rep < ((PROBE_MASK & 4) ? 2 : 1); ++rep) { prep_phase(p, lds); grid.sync(); }
    for (int ph = 1; ph < NPHASES; ++ph) {
        const Phase* P = tab + ph;
        const int type = uload32(&P->type);
        int nrep = 1;
        if (PROBE_MASK & 1) { if (type == PT_GEMM && uload32(&P->g[0].e.kind) == EK_FFN1) nrep = 2; }
        if (PROBE_MASK & 2) { if (type == PT_SCAN) nrep = 2; }
        if (PROBE_MASK & 16) { if (type == PT_LNV || type == PT_SPATIAL) nrep = 2; }
        if (PROBE_MASK & 32) { if (type == PT_SHIFT || type == PT_CONV) nrep = 2; }
        for (int rep = 0; rep < nrep; ++rep) {
        if (PROBE_MASK & 8) grid.sync();
        switch (type) {
            case PT_GEMM: { const int ng = uload32(&P->ng); for (int gi = 0; gi < ng; ++gi) { const GemmDesc* g = &P->g[gi]; if (!((PROBE_MASK & 128) && rep == 1)) gemm_big(lds, g, !((PROBE_MASK & 256) && rep == 1)); if (!((PROBE_MASK & 64) && rep == 1)) gemm_small(lds, g); } } break;
            case PT_LN: ln_phase(p, uload32(&P->a0), uload32(&P->a1), uload32(&P->a2) != 0); break;
            case PT_SHIFT: shift_phase(p); break;
            case PT_LNV: lnv_phase(p, uload32(&P->a0)); break;
            case PT_SPATIAL: spatial_phase(p, uload32(&P->a0), lds); break;
            case PT_CONV: conv_phase(p); break;
            default: scan_phase(p, lds); break;
        }
        grid.sync();
        }
    }
}

extern "C" void kernel_launch(void* const* d_in, const int* in_sizes, int n_in, void* d_out, int out_size, void* d_ws, size_t ws_size, hipStream_t stream) {
    static int grid_blocks = 0;
    if (grid_blocks == 0) {
        if (n_in != 39 || ws_size < WS_END) { fprintf(stderr, "kernel_launch: need 39 inputs and %zu bytes of workspace, got %d / %zu\n", (size_t)WS_END, n_in, ws_size); grid_blocks = -1; return; }
        int dev = 0, cus = 0, per_cu = 0;
        hipGetDevice(&dev); hipDeviceGetAttribute(&cus, hipDeviceAttributeMultiprocessorCount, dev);
        if (hipFuncSetAttribute((const void*)fwd_megakernel, hipFuncAttributeMaxDynamicSharedMemorySize, LDS_BYTES) != hipSuccess) { fprintf(stderr, "kernel_launch: hipFuncSetAttribute failed\n"); grid_blocks = -1; return; }
        hipOccupancyMaxActiveBlocksPerMultiprocessor(&per_cu, (const void*)fwd_megakernel, 512, LDS_BYTES);
        if (per_cu < 1) { fprintf(stderr, "kernel_launch: occupancy query says %d blocks per CU\n", per_cu); per_cu = 1; }
        (void)hipGetLastError();
        grid_blocks = cus;
    }
    if (grid_blocks < 0) return;
    Params p{};
    for (int i = 0; i < 39; ++i) p.in[i] = (const float*)d_in[i];
    p.out = (float*)d_out; p.ws = (unsigned char*)d_ws;
    void* args[] = {&p};
    hipError_t e = hipLaunchCooperativeKernel((const void*)fwd_megakernel, dim3(grid_blocks), dim3(512), args, LDS_BYTES, stream);
    if (e != hipSuccess) fprintf(stderr, "cooperative launch failed: %s (grid %d)\n", hipGetErrorString(e), grid_blocks);
}
```

```cpp
#include <hip/hip_runtime.h>
#include <hip/hip_cooperative_groups.h>
#include <cstdio>
namespace cg = cooperative_groups;

#define LAS __attribute__((address_space(3)))
#define GAS __attribute__((address_space(1)))
typedef unsigned short bf16_t;
typedef short bf16x8 __attribute__((ext_vector_type(8)));
typedef float f32x4 __attribute__((ext_vector_type(4)));
typedef float f32x2 __attribute__((ext_vector_type(2)));
typedef unsigned u32x4 __attribute__((ext_vector_type(4)));
typedef unsigned u32x2 __attribute__((ext_vector_type(2)));

constexpr int D = 1024, MP = 16384, MS = 512, MT = MP + MS, DFF = 2816;
constexpr float ALPHA = 1.6817928305074290f;
constexpr int BM = 256, BK = 64, HALF = 128, HTB = HALF * BK * 2, STAGE_BYTES = 8 * HTB, NXCD = 8, WGM = 8;
constexpr int LDS_BYTES = STAGE_BYTES;

constexpr size_t SZ_ROWF = (size_t)MT * 1024 * 4;
constexpr size_t W_FFN_IN = 0;
constexpr size_t W_FFN_OUT = W_FFN_IN + (size_t)8 * 5632 * 1024 * 2;
constexpr size_t W_PLE_G = W_FFN_OUT + (size_t)8 * 1024 * 2816 * 2;
constexpr size_t W_PLE_P = W_PLE_G + (size_t)4 * 1024 * 1024 * 2;
constexpr size_t W_A_IN = W_PLE_P + (size_t)4 * 1024 * 256 * 2;
constexpr size_t W_A_OUT = W_A_IN + (size_t)2 * 4096 * 1024 * 2;
constexpr size_t W_A_S = W_A_OUT + (size_t)2 * 1024 * 2048 * 2;
constexpr size_t W_B_IN = W_A_S + (size_t)2 * 8 * 128 * 128 * 2;
constexpr size_t W_B_L2 = W_B_IN + (size_t)3328 * 2048 * 2;
constexpr size_t W_B_O = W_B_L2 + (size_t)3072 * 256 * 2;
constexpr size_t W_C_IN = W_B_O + (size_t)1024 * 1024 * 2;
constexpr size_t W_C_OUT = W_C_IN + (size_t)3072 * 1024 * 2;
constexpr size_t A_XB = W_C_OUT + (size_t)1024 * 1024 * 2;
constexpr size_t A_ACT = A_XB + (size_t)MT * 1024 * 2;
constexpr size_t A_PB = A_ACT + (size_t)MT * 2816 * 2;
constexpr size_t A_PP = A_PB + (size_t)MT * 256 * 2;
constexpr size_t A_MIX = A_PP + SZ_ROWF;
constexpr size_t A_TAB = A_MIX + 4 * SZ_ROWF;
constexpr size_t A_BAR = A_TAB + 65536;
constexpr size_t WS_END = A_BAR + 16384;
constexpr size_t A_XBALT = A_MIX;
constexpr size_t A_U = A_MIX, A_V = A_MIX + (size_t)MT * 2048 * 2, A_VN = A_V + (size_t)MT * 2048 * 4, A_YB = A_ACT;
constexpr size_t A_R = A_MIX, A_DEC = A_MIX + 3 * SZ_ROWF, A_AA = A_ACT, A_GG = A_ACT + (size_t)MT * 1024 * 2, A_T = A_GG + (size_t)MT * 1024 * 2;
constexpr size_t A_XCAT = A_PP, A_OUTPRE = A_PP;
constexpr size_t A_Z = A_MIX, A_BG = A_MIX + SZ_ROWF, A_YC = A_ACT;
static_assert(A_VN + (size_t)MP * 2048 * 2 <= WS_END, "mix region");

constexpr size_t O_Y = 0, O_AV = (size_t)MT * 1024, O_WKVP = O_AV + (size_t)2 * 512 * 2048, O_SHP = O_WKVP + 524288, O_CVP = O_SHP + 8192,
                 O_WKVS = O_CVP + 16384, O_SHS = O_WKVS + 8388608, O_CVS = O_SHS + 131072;

struct Params { const float* in[39]; float* out; unsigned char* ws; };
struct Ctx { int tid; unsigned char* ws; float* out; };
__device__ __forceinline__ Ctx mkctx(const Params& p) { Ctx c; c.tid = threadIdx.x; size_t z = 0; asm volatile("" : "+v"(c.tid)); asm volatile("" : "+s"(z)); c.ws = p.ws + z; c.out = p.out + z; return c; }
__device__ __forceinline__ int uload32(const void* p) { return __builtin_amdgcn_readfirstlane(*(const volatile int*)p); }
template <class T> __device__ __forceinline__ T* uloadp(const void* p) { const unsigned lo = (unsigned)uload32(p), hi = (unsigned)uload32((const char*)p + 4); return (T*)(((unsigned long long)hi << 32) | lo); }

__device__ __forceinline__ unsigned cvt_pk_bf16(float lo, float hi) { unsigned r; asm("v_cvt_pk_bf16_f32 %0, %1, %2" : "=v"(r) : "v"(lo), "v"(hi)); return r; }
__device__ __forceinline__ float bf2f(unsigned short b) { return __uint_as_float(((unsigned)b) << 16); }
__device__ __forceinline__ f32x4 bf4_to_f4(u32x2 w) { return (f32x4){__uint_as_float(w.x << 16), __uint_as_float(w.x & 0xffff0000u), __uint_as_float(w.y << 16), __uint_as_float(w.y & 0xffff0000u)}; }
__device__ __forceinline__ u32x2 f4_to_bf4(f32x4 v) { u32x2 w; w.x = cvt_pk_bf16(v[0], v[1]); w.y = cvt_pk_bf16(v[2], v[3]); return w; }
__device__ __forceinline__ float wave_sum(float v) {
#pragma unroll
    for (int o = 32; o >= 1; o >>= 1) v += __shfl_xor(v, o);
    return v; }
template <int CTRL> __device__ __forceinline__ float dppmov(float v) { return __int_as_float(__builtin_amdgcn_update_dpp(0, __float_as_int(v), CTRL, 0xF, 0xF, true)); }
__device__ __forceinline__ float red16(float v) { v += dppmov<0xB1>(v); v += dppmov<0x4E>(v); v += dppmov<0x141>(v); v += dppmov<0x140>(v); return v; }
__device__ __forceinline__ float sigmoidf_(float x) { return 1.0f / (1.0f + __expf(-x)); }
__device__ __forceinline__ float tanh_(float x) { const float e = __expf(-2.0f * fabsf(x)); const float t = (1.0f - e) / (1.0f + e); return x < 0.f ? -t : t; }
__device__ __forceinline__ float decay_(float w) { const float sp = fmaxf(-w, 0.f) + __logf(1.0f + __expf(-fabsf(w))); return __expf(-__expf(-sp - 0.5f)); }
__device__ __forceinline__ f32x2 gelu_pk(f32x2 v) {
    const f32x2 av = __builtin_elementwise_abs(v), d = av * 0.2316418882f + 1.0f;
    f32x2 t; t.x = __builtin_amdgcn_rcpf(d.x); t.y = __builtin_amdgcn_rcpf(d.y);
    f32x2 q = t * 0.5307027145f + (-0.7265760135f); q = q * t + 0.7107068705f; q = q * t + (-0.142248368f); q = q * t + 0.127414796f; q = q * t;
    const f32x2 s = (v * v) * (-0.72134752044f);
    f32x2 e; e.x = __builtin_amdgcn_exp2f(s.x); e.y = __builtin_amdgcn_exp2f(s.y);
    const f32x2 m = v * (q * e), r = v - m;
    f32x2 o; o.x = v.x < 0.f ? m.x : r.x; o.y = v.y < 0.f ? m.y : r.y; return o;
}
__device__ __forceinline__ f32x4 gelu4(f32x4 v) { f32x2 a = gelu_pk((f32x2){v[0], v[1]}), b = gelu_pk((f32x2){v[2], v[3]}); return (f32x4){a.x, a.y, b.x, b.y}; }

enum { EK_FFN1 = 0, EK_RES, EK_GELU_UV, EK_STORE, EK_CONVZ, EK_PLE, EK_BIN, EK_BL2 };
struct Epi { int kind; float* f0; bf16_t* h0; bf16_t* h1; const float* c0; const float* c1; float scale; int ld; };
struct GemmDesc { const bf16_t* A; const bf16_t* Bt; int lda, ldb, K, nN; Epi e; };
struct EpiG { int kind; GAS float* f0; GAS bf16_t* h0; GAS bf16_t* h1; const GAS float* c0; const GAS float* c1; float scale; int ld; };
__device__ __forceinline__ EpiG load_epi(const GemmDesc* g) { EpiG e; e.kind = uload32(&g->e.kind); e.f0 = (GAS float*)uloadp<float>(&g->e.f0); e.h0 = (GAS bf16_t*)uloadp<bf16_t>(&g->e.h0); e.h1 = (GAS bf16_t*)uloadp<bf16_t>(&g->e.h1);
    e.c0 = (const GAS float*)uloadp<const float>(&g->e.c0); e.c1 = (const GAS float*)uloadp<const float>(&g->e.c1); e.scale = __int_as_float(uload32(&g->e.scale)); e.ld = uload32(&g->e.ld); return e; }

template <int KIND> __device__ __forceinline__ void epi_elem(const EpiG& e, int row, int col, f32x4 v0, f32x4 v1) {
    if (KIND == EK_FFN1) {
        f32x4 o;
#pragma unroll
        for (int j = 0; j < 4; ++j) o[j] = v0[j] * __builtin_amdgcn_rcpf(1.0f + __expf(-v0[j])) * v1[j];
        *(GAS u32x2*)(e.h0 + (size_t)row * DFF + col) = f4_to_bf4(o);
    } else if (KIND == EK_RES) {
        GAS float* p = e.f0 + (size_t)row * 1024 + col; const f32x4 x = *(const f32x4*)p; *(f32x4*)p = x * ALPHA + v0 * e.scale;
    } else if (KIND == EK_GELU_UV) {
        const f32x4 b = *(const GAS f32x4*)(e.c0 + col); const f32x4 g = gelu4(v0 + b);
        if (col < 2048) *(GAS u32x2*)(e.h0 + (size_t)row * 2048 + col) = f4_to_bf4(g);
        else *(GAS f32x4*)(e.f0 + (size_t)row * 2048 + (col - 2048)) = g;
    } else if (KIND == EK_STORE) {
        *(GAS f32x4*)(e.f0 + (size_t)row * e.ld + col) = v0;
    } else if (KIND == EK_CONVZ) {
        *(GAS f32x4*)(e.f0 + (size_t)row * 1024 + col) = v0 * v1;
    } else if (KIND == EK_PLE) {
        GAS float* p = e.f0 + (size_t)row * 1024 + col; f32x4 x = *(const f32x4*)p; const f32x4 pp = *(const GAS f32x4*)(e.c0 + (size_t)row * 1024 + col);
#pragma unroll
        for (int j = 0; j < 4; ++j) x[j] += pp[j] * __builtin_amdgcn_rcpf(1.0f + __expf(-v0[j]));
        *(f32x4*)p = x; *(GAS u32x2*)(e.h0 + (size_t)row * 1024 + col) = f4_to_bf4(x);
    } else if (KIND == EK_BIN) {
        if (col < 3072) { const int t = col >> 10; *(GAS f32x4*)(e.f0 + (size_t)t * ((size_t)MT * 1024) + (size_t)row * 1024 + (col & 1023)) = v0; }
        else { const int c = col - 3072; f32x4 o;
            if (c < 64) { o[0] = tanh_(v0[0]); o[1] = tanh_(v0[1]); o[2] = tanh_(v0[2]); o[3] = tanh_(v0[3]); }
            else if (c < 128) o = v0;
            else { o[0] = sigmoidf_(v0[0]); o[1] = sigmoidf_(v0[1]); o[2] = sigmoidf_(v0[2]); o[3] = sigmoidf_(v0[3]); }
            *(GAS u32x2*)(e.h0 + (size_t)row * 256 + c) = f4_to_bf4(o); }
    } else if (KIND == EK_BL2) {
        if (col < 1024) { const f32x4 w0 = *(const GAS f32x4*)(e.c0 + col); f32x4 o;
#pragma unroll
            for (int j = 0; j < 4; ++j) o[j] = decay_(w0[j] + v0[j]);
            *(GAS f32x4*)(e.f0 + (size_t)row * 1024 + col) = o;
        } else if (col < 2048) { const int c = col - 1024; const f32x4 a0 = *(const GAS f32x4*)(e.c1 + c); f32x4 o;
#pragma unroll
            for (int j = 0; j < 4; ++j) o[j] = sigmoidf_(a0[j] + v0[j]);
            *(GAS u32x2*)(e.h0 + (size_t)row * 1024 + c) = f4_to_bf4(o);
        } else { *(GAS u32x2*)(e.h1 + (size_t)row * 1024 + (col - 2048)) = f4_to_bf4(v0); }
    }
}
template <int KIND> __device__ __forceinline__ void epi_big(const GemmDesc* gd, const f32x4 (&acc)[2][2][4][2], int pm, int pn, int wr, int wc, int fr, int fq) {
    constexpr bool PAIRED = (KIND == EK_FFN1 || KIND == EK_CONVZ);
    const EpiG e = load_epi(gd);
#pragma unroll
    for (int ai = 0; ai < 2; ++ai)
#pragma unroll
        for (int m = 0; m < 4; ++m) {
            if (m & 1) asm volatile("" ::: "memory");
            const int row = pm * BM + ai * HALF + wr * 64 + m * 16 + fr;
#pragma unroll
            for (int n = 0; n < 2; ++n) {
                if (PAIRED) epi_elem<KIND>(e, row, pn * 128 + wc * 32 + n * 16 + fq * 4, acc[ai][0][m][n], acc[ai][1][m][n]);
                else {
#pragma unroll
                    for (int bj = 0; bj < 2; ++bj) epi_elem<KIND>(e, row, pn * BM + bj * HALF + wc * 32 + n * 16 + fq * 4, acc[ai][bj][m][n], acc[ai][bj][m][n]);
                }
            }
        }
}

__device__ __forceinline__ int lds_byte(int r, int c) { const int st = (r >> 4) * 2 + (c >> 5), rr = r & 15, cc = c & 31, ob = rr * 64 + cc * 2; return st * 1024 + (ob ^ (((ob >> 9) & 1) << 5)); }
__device__ __forceinline__ void stage_rc(int b, int& R, int& C) { const int st = b / 1024, sb = b % 1024, swz = sb ^ (((sb >> 9) & 1) << 5); R = (st >> 1) * 16 + swz / 64; C = (st & 1) * 32 + (swz % 64) / 2; }
struct Unit { int pm, pn; };
struct StaticOrder {
    int nM, nN, nwg, G, c;
    __device__ void init(int nM_, int nN_, int G_, int c_) { nM = nM_; nN = nN_; nwg = nM * nN; G = G_; c = c_; }
    __device__ bool next(int i, Unit& u) const {
        const long L = (long)i * G + c; if (L >= nwg) return false;
        int wgid = (int)L; { const int q = nwg / NXCD, r = nwg % NXCD, xcd = wgid % NXCD, off = wgid / NXCD; wgid = (xcd < r ? xcd * (q + 1) : r * (q + 1) + (xcd - r) * q) + off; }
        const int nig = WGM * nN, gid = wgid / nig, fm = gid * WGM, gsz = (nM - fm) < WGM ? (nM - fm) : WGM;
        u.pm = fm + ((wgid % nig) % gsz); u.pn = (wgid % nig) / gsz; return true;
    }
};

__device__ __forceinline__ void gemm_big(LAS unsigned char* lds, const GemmDesc* gd, const bool do_epi = true) {
    int tid_ = threadIdx.x; asm volatile("" : "+v"(tid_));
    const int tid = tid_, wid = __builtin_amdgcn_readfirstlane(tid >> 6), lane = tid & 63, wr = wid >> 2, wc = wid & 3, fr = lane & 15, fq = lane >> 4;
    struct { const bf16_t* A; const bf16_t* Bt; int lda, ldb, K, nN; } g;
    g.A = uloadp<const bf16_t>(&gd->A); g.Bt = uloadp<const bf16_t>(&gd->Bt); g.lda = uload32(&gd->lda); g.ldb = uload32(&gd->ldb); g.K = uload32(&gd->K); g.nN = uload32(&gd->nN);
    const int ekind = uload32(&gd->e.kind);
    const int K = g.K, nt = K / BK;
    StaticOrder S; S.init(MP / BM, g.nN, gridDim.x, blockIdx.x);
    unsigned voffA[2], voffB[2];
#pragma unroll
    for (int i = 0; i < 2; ++i) { int R, C; stage_rc(tid * 16 + i * 8192, R, C); voffA[i] = (unsigned)(R * g.lda + C) * 2u; voffB[i] = (unsigned)(R * g.ldb + C) * 2u; }
    const size_t kstep = (size_t)(BK * 2);
    const size_t hstepA = (size_t)HALF * g.lda * 2, hstepB = (size_t)HALF * g.ldb * 2;
    const size_t tstepA = 2 * hstepA, tstepB = 2 * hstepB;
    const unsigned ldsw = (unsigned)wid * 1024u;
    const int aoff = lds_byte(wr * 64 + fr, fq * 8), boff = lds_byte(wc * 32 + fr, fq * 8);
#define PG8_SA(b, h) (((b) * 2 + (h)) * HTB)
#define PG8_SB(b, h) ((4 + (b) * 2 + (h)) * HTB)
#define PG8_STAGE(bufoff, gbase, voff) do { _Pragma("unroll") for (int _i = 0; _i < 2; ++_i) \
        __builtin_amdgcn_global_load_lds((const unsigned*)((const char*)(gbase) + (voff)[_i]), (LAS unsigned*)(lds + (bufoff) + ldsw + _i * 8192), 16, 0, 0); } while (0)
#define PG8_LDA(dst, b, h) do { _Pragma("unroll") for (int m = 0; m < 4; ++m) _Pragma("unroll") for (int k = 0; k < 2; ++k) dst[m][k] = *(const LAS bf16x8*)(lds + PG8_SA(b, h) + aoff + m * 2048 + k * 1024); } while (0)
#define PG8_LDB(dst, b, h) do { _Pragma("unroll") for (int n = 0; n < 2; ++n) _Pragma("unroll") for (int k = 0; k < 2; ++k) dst[n][k] = *(const LAS bf16x8*)(lds + PG8_SB(b, h) + boff + n * 2048 + k * 1024); } while (0)
#define PG8_MMA(ai, bj, At, Bt) do { __builtin_amdgcn_s_setprio(1); _Pragma("unroll") for (int m = 0; m < 4; ++m) _Pragma("unroll") for (int n = 0; n < 2; ++n) _Pragma("unroll") for (int k = 0; k < 2; ++k) \
        acc[ai][bj][m][n] = __builtin_amdgcn_mfma_f32_16x16x32_bf16(Bt[n][k], At[m][k], acc[ai][bj][m][n], 0, 0, 0); __builtin_amdgcn_s_setprio(0); } while (0)
#define PG8_WAIT_V(n) asm volatile("s_waitcnt vmcnt(" #n ")" ::: "memory")
#define PG8_WAIT_L(n) asm volatile("s_waitcnt lgkmcnt(" #n ")" ::: "memory")
#define PG8_BAR __builtin_amdgcn_s_barrier()
#define PG8_SCHED __builtin_amdgcn_sched_barrier(0)
    Unit cur, nxt; int ui = 0;
    if (!S.next(0, cur)) return;
    f32x4 acc[2][2][4][2];
#pragma unroll
    for (int a = 0; a < 2; ++a)
#pragma unroll
        for (int b = 0; b < 2; ++b)
#pragma unroll
            for (int m = 0; m < 4; ++m)
#pragma unroll
                for (int n = 0; n < 2; ++n) acc[a][b][m][n] = (f32x4){0.f, 0.f, 0.f, 0.f};
    bf16x8 At[4][2], B0[2][2], B1[2][2];
    const char* cA = (const char*)g.A + (size_t)cur.pm * tstepA; const char* cB = (const char*)g.Bt + (size_t)cur.pn * tstepB;
    PG8_STAGE(PG8_SB(0, 0), cB, voffB); PG8_STAGE(PG8_SA(0, 0), cA, voffA); PG8_STAGE(PG8_SB(0, 1), cB + hstepB, voffB); PG8_STAGE(PG8_SA(0, 1), cA + hstepA, voffA);
    if (wr == 1) PG8_BAR;
    PG8_WAIT_V(4); PG8_BAR;
    PG8_STAGE(PG8_SB(1, 0), cB + kstep, voffB); PG8_STAGE(PG8_SA(1, 0), cA + kstep, voffA); PG8_STAGE(PG8_SB(1, 1), cB + hstepB + kstep, voffB);
    PG8_WAIT_V(6); PG8_BAR;
    for (;;) {
        const bool has_next = S.next(ui + 1, nxt);
        const char* nA = has_next ? (const char*)g.A + (size_t)nxt.pm * tstepA : cA; const char* nB = has_next ? (const char*)g.Bt + (size_t)nxt.pn * tstepB : cB;
        for (int t = 0; t < nt; t += 2) {
            const bool last = (t == nt - 2);
            const char* a1 = cA + (size_t)(t + 1) * kstep;
            const char* a2 = last ? nA : cA + (size_t)(t + 2) * kstep; const char* b2 = last ? nB : cB + (size_t)(t + 2) * kstep;
            const char* a3 = a2 + kstep; const char* b3 = b2 + kstep;
            PG8_LDB(B0, 0, 0); PG8_SCHED; PG8_LDA(At, 0, 0); PG8_STAGE(PG8_SA(1, 1), a1 + hstepA, voffA);
            PG8_WAIT_L(8); PG8_BAR; PG8_WAIT_L(0); PG8_MMA(0, 0, At, B0); PG8_BAR; PG8_SCHED;
            PG8_LDB(B1, 0, 1); PG8_STAGE(PG8_SB(0, 0), b2, voffB);
            PG8_BAR; PG8_WAIT_L(0); PG8_MMA(0, 1, At, B1); PG8_BAR;
            PG8_LDA(At, 0, 1); PG8_STAGE(PG8_SA(0, 0), a2, voffA);
            PG8_BAR; PG8_WAIT_L(0); PG8_MMA(1, 0, At, B0); PG8_BAR; PG8_SCHED;
            PG8_STAGE(PG8_SB(0, 1), b2 + hstepB, voffB);
            PG8_WAIT_V(6); PG8_BAR; PG8_MMA(1, 1, At, B1); PG8_BAR;
            PG8_LDB(B0, 1, 0); PG8_SCHED; PG8_LDA(At, 1, 0); PG8_STAGE(PG8_SA(0, 1), a2 + hstepA, voffA);
            PG8_WAIT_L(8); PG8_BAR; PG8_WAIT_L(0); PG8_MMA(0, 0, At, B0); PG8_BAR; PG8_SCHED;
            PG8_LDB(B1, 1, 1); PG8_STAGE(PG8_SB(1, 0), b3, voffB);
            PG8_BAR; PG8_WAIT_L(0); PG8_MMA(0, 1, At, B1); PG8_BAR;
            PG8_LDA(At, 1, 1); PG8_STAGE(PG8_SA(1, 0), a3, voffA);
            PG8_BAR; PG8_WAIT_L(0); PG8_MMA(1, 0, At, B0); PG8_BAR; PG8_SCHED;
            PG8_STAGE(PG8_SB(1, 1), b3 + hstepB, voffB);
            PG8_WAIT_V(6); PG8_BAR; PG8_MMA(1, 1, At, B1); PG8_BAR;
        }
        if (do_epi) switch (ekind) {
            case EK_FFN1: epi_big<EK_FFN1>(gd, acc, cur.pm, cur.pn, wr, wc, fr, fq); break;
            case EK_RES: epi_big<EK_RES>(gd, acc, cur.pm, cur.pn, wr, wc, fr, fq); break;
            case EK_GELU_UV: epi_big<EK_GELU_UV>(gd, acc, cur.pm, cur.pn, wr, wc, fr, fq); break;
            case EK_STORE: epi_big<EK_STORE>(gd, acc, cur.pm, cur.pn, wr, wc, fr, fq); break;
            case EK_CONVZ: epi_big<EK_CONVZ>(gd, acc, cur.pm, cur.pn, wr, wc, fr, fq); break;
            case EK_PLE: epi_big<EK_PLE>(gd, acc, cur.pm, cur.pn, wr, wc, fr, fq); break;
            case EK_BIN: epi_big<EK_BIN>(gd, acc, cur.pm, cur.pn, wr, wc, fr, fq); break;
            default: epi_big<EK_BL2>(gd, acc, cur.pm, cur.pn, wr, wc, fr, fq); break;
        }
        if (!has_next) break;
#pragma unroll
        for (int a = 0; a < 2; ++a)
#pragma unroll
            for (int b = 0; b < 2; ++b)
#pragma unroll
                for (int m = 0; m < 4; ++m)
#pragma unroll
                    for (int n = 0; n < 2; ++n) acc[a][b][m][n] = (f32x4){0.f, 0.f, 0.f, 0.f};
        cur = nxt; cA = nA; cB = nB; ++ui;
    }
    PG8_WAIT_V(0);
    if (wr == 0) PG8_BAR;
    PG8_BAR;
#undef PG8_SA
#undef PG8_SB
#undef PG8_STAGE
#undef PG8_LDA
#undef PG8_LDB
#undef PG8_MMA
#undef PG8_WAIT_V
#undef PG8_WAIT_L
#undef PG8_BAR
#undef PG8_SCHED
}

template <int KIND> __device__ __forceinline__ void small_epi(const EpiG& e, int row, int col, f32x4 v0, f32x4 v1) { epi_elem<KIND>(e, row, col, v0, v1); }
__device__ __forceinline__ void gemm_small(LAS unsigned char* lds, const GemmDesc* gd) {
    int tid_ = threadIdx.x; asm volatile("" : "+v"(tid_));
    const int tid = tid_, wid = __builtin_amdgcn_readfirstlane(tid >> 6), lane = tid & 63, fr = lane & 15, fq = lane >> 4;
    struct { const GAS bf16_t* A; const GAS bf16_t* Bt; int lda, ldb, K, nN; } g;
    g.A = (const GAS bf16_t*)uloadp<const bf16_t>(&gd->A); g.Bt = (const GAS bf16_t*)uloadp<const bf16_t>(&gd->Bt); g.lda = uload32(&gd->lda); g.ldb = uload32(&gd->ldb); g.K = uload32(&gd->K); g.nN = uload32(&gd->nN);
    const int ekind = uload32(&gd->e.kind);
    const bool paired = (ekind == EK_FFN1 || ekind == EK_CONVZ);
    const int ncu = paired ? g.nN * 4 : g.nN * 4;
    const int nunits = 8 * ncu;
    const int kq = wid >> 1, nh = wid & 1;
    const int ks = g.K >> 2;
    LAS f32x4* P = (LAS f32x4*)lds;
    for (int su = (int)(gridDim.x - 1 - blockIdx.x); su < nunits; su += gridDim.x) {
        const int rp = su & 7, cu = su >> 3;
        const int row0 = MP + rp * 64;
        int brow[2];
#pragma unroll
        for (int j = 0; j < 2; ++j) { const int nb = nh * 2 + j;
            if (paired) { const int p0 = cu * 32; brow[j] = (p0 >> 7) * 256 + (nb >> 1) * 128 + (p0 & 127) + (nb & 1) * 16 + fr; }
            else brow[j] = cu * 64 + nb * 16 + fr; }
        const GAS bf16_t* ap = g.A + (size_t)(row0 + fr) * g.lda + kq * ks + fq * 8;
        const GAS bf16_t* bp0 = g.Bt + (size_t)brow[0] * g.ldb + kq * ks + fq * 8;
        const GAS bf16_t* bp1 = g.Bt + (size_t)brow[1] * g.ldb + kq * ks + fq * 8;
        f32x4 acc[4][2];
#pragma unroll
        for (int m = 0; m < 4; ++m) { acc[m][0] = (f32x4){0.f, 0.f, 0.f, 0.f}; acc[m][1] = (f32x4){0.f, 0.f, 0.f, 0.f}; }
#pragma unroll 2
        for (int k = 0; k < ks; k += 32) {
            bf16x8 a[4], b[2];
#pragma unroll
            for (int m = 0; m < 4; ++m) a[m] = *(const GAS bf16x8*)(ap + (size_t)(m * 16) * g.lda + k);
            b[0] = *(const GAS bf16x8*)(bp0 + k); b[1] = *(const GAS bf16x8*)(bp1 + k);
#pragma unroll
            for (int m = 0; m < 4; ++m) { acc[m][0] = __builtin_amdgcn_mfma_f32_16x16x32_bf16(b[0], a[m], acc[m][0], 0, 0, 0); acc[m][1] = __builtin_amdgcn_mfma_f32_16x16x32_bf16(b[1], a[m], acc[m][1], 0, 0, 0); }
        }
#pragma unroll
        for (int m = 0; m < 4; ++m)
#pragma unroll
            for (int j = 0; j < 2; ++j) P[((kq * 4 + m) * 4 + nh * 2 + j) * 64 + lane] = acc[m][j];
        __syncthreads();
        {   const int m = wid >> 1, s = wid & 1;
            f32x4 v0 = (f32x4){0.f, 0.f, 0.f, 0.f}, v1 = v0;
#pragma unroll
            for (int q = 0; q < 4; ++q) { v0 += P[((q * 4 + m) * 4 + s) * 64 + lane]; v1 += P[((q * 4 + m) * 4 + s + 2) * 64 + lane]; }
            const int row = row0 + m * 16 + fr;
            const int cA_ = paired ? cu * 32 + s * 16 + fq * 4 : cu * 64 + s * 16 + fq * 4;
            const int cB_ = cu * 64 + (s + 2) * 16 + fq * 4;
            const EpiG e = load_epi(gd);
            switch (ekind) {
                case EK_FFN1: small_epi<EK_FFN1>(e, row, cA_, v0, v1); break;
                case EK_CONVZ: small_epi<EK_CONVZ>(e, row, cA_, v0, v1); break;
                case EK_RES: small_epi<EK_RES>(e, row, cA_, v0, v0); small_epi<EK_RES>(e, row, cB_, v1, v1); break;
                case EK_GELU_UV: small_epi<EK_GELU_UV>(e, row, cA_, v0, v0); small_epi<EK_GELU_UV>(e, row, cB_, v1, v1); break;
                case EK_STORE: small_epi<EK_STORE>(e, row, cA_, v0, v0); small_epi<EK_STORE>(e, row, cB_, v1, v1); break;
                case EK_PLE: small_epi<EK_PLE>(e, row, cA_, v0, v0); small_epi<EK_PLE>(e, row, cB_, v1, v1); break;
                case EK_BIN: small_epi<EK_BIN>(e, row, cA_, v0, v0); small_epi<EK_BIN>(e, row, cB_, v1, v1); break;
                default: small_epi<EK_BL2>(e, row, cA_, v0, v0); small_epi<EK_BL2>(e, row, cB_, v1, v1); break;
            }
        }
        __syncthreads();
    }
}

__device__ __forceinline__ int srccol(int mode, int n0) {
    if (mode == 1) { const int pn = n0 >> 8, bj = (n0 >> 7) & 1, l = n0 & 127; return bj * DFF + pn * 128 + l; }
    if (mode == 2) { if (n0 < 2048) { const int pn = n0 >> 8, bj = (n0 >> 7) & 1, l = n0 & 127; return 1024 * (1 + bj) + pn * 128 + l; } return n0 - 2048; }
    return n0;
}
__device__ __forceinline__ void tconv(LAS float* tile, int& base, const float* src, int ld, int K, int ncols, bf16_t* dst, int ldd, int koff, int mode, const float* scale) {
    int tid_ = threadIdx.x; asm volatile("" : "+v"(tid_));
    const int nkt = K >> 6, ntl = nkt * (ncols >> 6), G = gridDim.x, tid = tid_;
    int t0 = ((int)blockIdx.x - (base % G) + G) % G; base += ntl;
    for (int t = t0; t < ntl; t += G) {
        const int kt = t % nkt, n0 = (t / nkt) * 64, k0 = kt * 64, sc0 = srccol(mode, n0);
        __syncthreads();
#pragma unroll
        for (int i = 0; i < 2; ++i) { const int kk = (tid >> 4) + i * 32, n4 = (tid & 15) * 4;
            f32x4 v = *(const f32x4*)(src + (size_t)(k0 + kk) * ld + sc0 + n4);
            if (scale) v = v * scale[k0 + kk];
#pragma unroll
            for (int j = 0; j < 4; ++j) tile[kk * 65 + n4 + j] = v[j]; }
        __syncthreads();
        { const int nn = tid >> 3, k8 = (tid & 7) * 8; u32x4 w;
            w.x = cvt_pk_bf16(tile[(k8 + 0) * 65 + nn], tile[(k8 + 1) * 65 + nn]); w.y = cvt_pk_bf16(tile[(k8 + 2) * 65 + nn], tile[(k8 + 3) * 65 + nn]);
            w.z = cvt_pk_bf16(tile[(k8 + 4) * 65 + nn], tile[(k8 + 5) * 65 + nn]); w.w = cvt_pk_bf16(tile[(k8 + 6) * 65 + nn], tile[(k8 + 7) * 65 + nn]);
            *(u32x4*)(dst + (size_t)(n0 + nn) * ldd + koff + k0 + k8) = w; }
    }
}
__device__ __forceinline__ void prep_phase(const Params& p, LAS unsigned char* lds) {
    const Ctx cx = mkctx(p);
    LAS float* tile = (LAS float*)lds; unsigned char* ws = cx.ws; int base = 0;
    const size_t gt = (size_t)blockIdx.x * 512 + cx.tid, gn = (size_t)gridDim.x * 512;
    for (int q = 0; q < 8; ++q) tconv(tile, base, p.in[9] + (size_t)q * 1024 * 5632, 5632, 1024, 5632, (bf16_t*)(ws + W_FFN_IN) + (size_t)q * 5632 * 1024, 1024, 0, 1, nullptr);
    for (int q = 0; q < 8; ++q) tconv(tile, base, p.in[10] + (size_t)q * 2816 * 1024, 1024, 2816, 1024, (bf16_t*)(ws + W_FFN_OUT) + (size_t)q * 1024 * 2816, 2816, 0, 0, nullptr);
    for (int i = 0; i < 4; ++i) tconv(tile, base, p.in[11] + (size_t)i * 1024 * 1024, 1024, 1024, 1024, (bf16_t*)(ws + W_PLE_G) + (size_t)i * 1024 * 1024, 1024, 0, 0, nullptr);
    for (int i = 0; i < 4; ++i) tconv(tile, base, p.in[12] + (size_t)i * 256 * 1024, 1024, 256, 1024, (bf16_t*)(ws + W_PLE_P) + (size_t)i * 1024 * 256, 256, 0, 0, nullptr);
    for (int j = 0; j < 2; ++j) tconv(tile, base, p.in[13] + (size_t)j * 1024 * 4096, 4096, 1024, 4096, (bf16_t*)(ws + W_A_IN) + (size_t)j * 4096 * 1024, 1024, 0, 0, nullptr);
    for (int j = 0; j < 2; ++j) tconv(tile, base, p.in[19] + (size_t)j * 2048 * 1024, 1024, 2048, 1024, (bf16_t*)(ws + W_A_OUT) + (size_t)j * 1024 * 2048, 2048, 0, 0, nullptr);
    bf16_t* bin = (bf16_t*)(ws + W_B_IN);
    for (int q = 0; q < 3; ++q) { const int mi = q == 0 ? 0 : (q == 1 ? 2 : 3);
        tconv(tile, base, p.in[21] + (size_t)q * 1024 * 1024, 1024, 1024, 1024, bin + (size_t)q * 1024 * 2048, 2048, 0, 0, nullptr);
        tconv(tile, base, p.in[21] + (size_t)q * 1024 * 1024, 1024, 1024, 1024, bin + (size_t)q * 1024 * 2048, 2048, 1024, 0, p.in[20] + mi * 1024); }
    tconv(tile, base, p.in[23], 64, 1024, 64, bin + (size_t)3072 * 2048, 2048, 0, 0, nullptr);
    tconv(tile, base, p.in[23], 64, 1024, 64, bin + (size_t)3072 * 2048, 2048, 1024, 0, p.in[20] + 1 * 1024);
    tconv(tile, base, p.in[26], 64, 1024, 64, bin + (size_t)3136 * 2048, 2048, 0, 0, nullptr);
    tconv(tile, base, p.in[26], 64, 1024, 64, bin + (size_t)3136 * 2048, 2048, 1024, 0, p.in[20] + 4 * 1024);
    tconv(tile, base, p.in[28], 128, 1024, 128, bin + (size_t)3200 * 2048, 2048, 0, 0, nullptr);
    tconv(tile, base, p.in[28], 128, 1024, 128, bin + (size_t)3200 * 2048, 2048, 1024, 0, p.in[20] + 5 * 1024);
    tconv(tile, base, p.in[35], 1024, 1024, 1024, (bf16_t*)(ws + W_B_O), 1024, 0, 0, nullptr);
    tconv(tile, base, p.in[36], 3072, 1024, 3072, (bf16_t*)(ws + W_C_IN), 1024, 0, 2, nullptr);
    tconv(tile, base, p.in[38], 1024, 1024, 1024, (bf16_t*)(ws + W_C_OUT), 1024, 0, 0, nullptr);
    { bf16_t* l2 = (bf16_t*)(ws + W_B_L2);
        for (size_t i = gt; i < (size_t)3072 * 256; i += gn) { const int n = (int)(i >> 8), k = (int)(i & 255); float v = 0.f;
            if (n < 1024) { if (k < 64) v = p.in[24][k * 1024 + n]; }
            else if (n < 2048) { if (k >= 64 && k < 128) v = p.in[27][(k - 64) * 1024 + (n - 1024)]; }
            else { if (k >= 128) v = p.in[29][(k - 128) * 1024 + (n - 2048)]; }
            l2[i] = (bf16_t)(cvt_pk_bf16(v, 0.f) & 0xffffu); } }
    { bf16_t* as = (bf16_t*)(ws + W_A_S);
        for (size_t i = gt; i < (size_t)2 * 8 * 128 * 128; i += gn) { const int s = (int)(i & 127), t = (int)((i >> 7) & 127); const float v = s <= t ? p.in[17][i] : 0.f; as[i] = (bf16_t)(cvt_pk_bf16(v, 0.f) & 0xffffu); } }
    { float* X = cx.out + O_Y; bf16_t* xb = (bf16_t*)(ws + A_XBALT);
        for (size_t i = gt; i < (size_t)MT * 256; i += gn) { const size_t e = i * 4; const f32x4 v = e < (size_t)MP * 1024 ? *(const f32x4*)(p.in[0] + e) : *(const f32x4*)(p.in[1] + (e - (size_t)MP * 1024));
            *(f32x4*)(X + e) = v; *(u32x2*)(xb + e) = f4_to_bf4(v); } }
}

__device__ __forceinline__ void ln_phase(const Params& p, int layer, int which, bool write_pb) {
    const Ctx cx = mkctx(p);
    const int lane = cx.tid & 63, gw = blockIdx.x * 8 + (cx.tid >> 6), nw = gridDim.x * 8;
    float* X = cx.out + O_Y; bf16_t* xb = (bf16_t*)(cx.ws + A_XB);
    const float* g = p.in[7] + (size_t)(layer * 3 + which) * 1024; const float* b = p.in[8] + (size_t)(layer * 3 + which) * 1024;
    f32x4 gv[4], bv[4];
#pragma unroll
    for (int i = 0; i < 4; ++i) { gv[i] = *(const f32x4*)(g + i * 256 + lane * 4); bv[i] = *(const f32x4*)(b + i * 256 + lane * 4); }
    for (int row = gw; row < MT; row += nw) {
        f32x4 v[4]; float s = 0.f;
#pragma unroll
        for (int i = 0; i < 4; ++i) { v[i] = *(const f32x4*)(X + (size_t)row * 1024 + i * 256 + lane * 4); s += (v[i][0] + v[i][1]) + (v[i][2] + v[i][3]); }
        const float mean = wave_sum(s) * (1.0f / 1024.0f); float q = 0.f;
#pragma unroll
        for (int i = 0; i < 4; ++i) { v[i] = v[i] - mean; q += (v[i][0] * v[i][0] + v[i][1] * v[i][1]) + (v[i][2] * v[i][2] + v[i][3] * v[i][3]); }
        const float rstd = rsqrtf(wave_sum(q) * (1.0f / 1024.0f) + 1e-5f);
#pragma unroll
        for (int i = 0; i < 4; ++i) { const f32x4 y = v[i] * rstd * gv[i] + bv[i]; *(f32x4*)(X + (size_t)row * 1024 + i * 256 + lane * 4) = y; *(u32x2*)(xb + (size_t)row * 1024 + i * 256 + lane * 4) = f4_to_bf4(y); }
    }
    if (write_pb) { bf16_t* pb = (bf16_t*)(cx.ws + A_PB); const size_t gt = (size_t)blockIdx.x * 512 + cx.tid, gn = (size_t)gridDim.x * 512;
        for (size_t i = gt; i < (size_t)MT * 64; i += gn) { const size_t e = i * 4; const f32x4 v = e < (size_t)MP * 256 ? *(const f32x4*)(p.in[5] + (size_t)layer * MP * 256 + e) : *(const f32x4*)(p.in[6] + (size_t)layer * MS * 256 + (e - (size_t)MP * 256));
            *(u32x2*)(pb + e) = f4_to_bf4(v); } }
}
__device__ __forceinline__ void shift_phase(const Params& p0) {
    const Ctx cx = mkctx(p0); Params p = p0; p.ws = cx.ws; p.out = cx.out;
    const int lane = cx.tid & 63, gw = blockIdx.x * 8 + (cx.tid >> 6), nw = gridDim.x * 8;
    const float* X = p.out + O_Y; bf16_t* xc = (bf16_t*)(p.ws + A_XCAT);
    for (int row = gw; row < MT; row += nw) {
        int b, t, T; const float* prevp; float* shout;
        if (row < MP) { b = row >> 11; t = row & 2047; T = 2048; prevp = nullptr; shout = p.out + O_SHP + (size_t)b * 1024; }
        else { const int r = row - MP; b = r >> 2; t = r & 3; T = 4; prevp = p.in[3] + (size_t)b * 1024; shout = p.out + O_SHS + (size_t)b * 1024; }
        if (t > 0) prevp = X + (size_t)(row - 1) * 1024;
#pragma unroll
        for (int i = 0; i < 4; ++i) { const int c = i * 256 + lane * 4; const f32x4 x = *(const f32x4*)(X + (size_t)row * 1024 + c);
            const f32x4 pv = prevp ? *(const f32x4*)(prevp + c) : (f32x4){0.f, 0.f, 0.f, 0.f};
            *(u32x2*)(xc + (size_t)row * 2048 + c) = f4_to_bf4(x); *(u32x2*)(xc + (size_t)row * 2048 + 1024 + c) = f4_to_bf4(pv - x);
            if (t == T - 1) *(f32x4*)(shout + c) = x; }
    }
}
__device__ __forceinline__ void lnv_phase(const Params& p0, int jA) {
    const Ctx cx = mkctx(p0); Params p = p0; p.ws = cx.ws; p.out = cx.out;
    const int lane = cx.tid & 63, gw = blockIdx.x * 8 + (cx.tid >> 6), nw = gridDim.x * 8;
    const float* V = (const float*)(p.ws + A_V); bf16_t* vn = (bf16_t*)(p.ws + A_VN);
    const float* g = p.in[15] + (size_t)jA * 2048; const float* b = p.in[16] + (size_t)jA * 2048;
    for (int row = gw; row < MP; row += nw) {
        f32x4 v[8]; float s = 0.f;
#pragma unroll
        for (int i = 0; i < 8; ++i) { v[i] = *(const f32x4*)(V + (size_t)row * 2048 + i * 256 + lane * 4); s += (v[i][0] + v[i][1]) + (v[i][2] + v[i][3]); }
        const float mean = wave_sum(s) * (1.0f / 2048.0f); float q = 0.f;
#pragma unroll
        for (int i = 0; i < 8; ++i) { v[i] = v[i] - mean; q += (v[i][0] * v[i][0] + v[i][1] * v[i][1]) + (v[i][2] * v[i][2] + v[i][3] * v[i][3]); }
        const float rstd = rsqrtf(wave_sum(q) * (1.0f / 2048.0f) + 1e-5f);
#pragma unroll
        for (int i = 0; i < 8; ++i) { const int c = i * 256 + lane * 4; const f32x4 y = v[i] * rstd * *(const f32x4*)(g + c) + *(const f32x4*)(b + c); *(u32x2*)(vn + (size_t)row * 2048 + c) = f4_to_bf4(y); }
    }
    const bf16_t* U = (const bf16_t*)(p.ws + A_U); bf16_t* yb = (bf16_t*)(p.ws + A_YB);
    const float* wsp = p.in[17] + (size_t)jA * 8 * 128 * 128; const float* bsp = p.in[18] + (size_t)jA * 8 * 128;
    for (int bb = nw - 1 - gw; bb < 128; bb += nw) {
        float mean[4], rstd[4];
#pragma unroll
        for (int t = 0; t < 4; ++t) { const int row = MP + bb * 4 + t; f32x4 v[8]; float s = 0.f;
#pragma unroll
            for (int i = 0; i < 8; ++i) { v[i] = *(const f32x4*)(V + (size_t)row * 2048 + i * 256 + lane * 4); s += (v[i][0] + v[i][1]) + (v[i][2] + v[i][3]); }
            mean[t] = wave_sum(s) * (1.0f / 2048.0f); float q = 0.f;
#pragma unroll
            for (int i = 0; i < 8; ++i) { v[i] = v[i] - mean[t]; q += (v[i][0] * v[i][0] + v[i][1] * v[i][1]) + (v[i][2] * v[i][2] + v[i][3] * v[i][3]); }
            rstd[t] = rsqrtf(wave_sum(q) * (1.0f / 2048.0f) + 1e-5f); }
        for (int i = 0; i < 8; ++i) { const int c = i * 256 + lane * 4, h = i;
            const f32x4 g4 = *(const f32x4*)(g + c), b4 = *(const f32x4*)(b + c); f32x4 n[4];
#pragma unroll
            for (int t = 0; t < 4; ++t) { const int row = MP + bb * 4 + t; n[t] = (*(const f32x4*)(V + (size_t)row * 2048 + c) - mean[t]) * rstd[t] * g4 + b4;
                *(f32x4*)(p.out + O_AV + ((size_t)jA * 512 + bb * 4 + t) * 2048 + c) = n[t]; }
#pragma unroll
            for (int t = 0; t < 4; ++t) { const int row = MP + bb * 4 + t; const float bs = bsp[h * 128 + t]; f32x4 mx = (f32x4){bs, bs, bs, bs};
#pragma unroll
                for (int s = 0; s <= t; ++s) mx += n[s] * wsp[(h * 128 + t) * 128 + s];
                const f32x4 u = bf4_to_f4(*(const u32x2*)(U + (size_t)row * 2048 + c)); *(u32x2*)(yb + (size_t)row * 2048 + c) = f4_to_bf4(u * mx); }
        }
    }
}
__device__ __forceinline__ void spatial_phase(const Params& p0, int jA, LAS unsigned char* lds) {
    const Ctx cx = mkctx(p0); Params p = p0; p.ws = cx.ws; p.out = cx.out;
    const int tid = cx.tid, wid = tid >> 6, lane = tid & 63, fr = lane & 15, fq = lane >> 4;
    const bf16_t* vn = (const bf16_t*)(p.ws + A_VN); const bf16_t* U = (const bf16_t*)(p.ws + A_U); bf16_t* yb = (bf16_t*)(p.ws + A_YB);
    const bf16_t* was = (const bf16_t*)(p.ws + W_A_S) + (size_t)jA * 8 * 128 * 128; const float* bsp = p.in[18] + (size_t)jA * 8 * 128;
    constexpr int RS = 516;
    for (int u = blockIdx.x; u < 1024; u += gridDim.x) {
        const int c = u >> 3, h = u & 7;
        __syncthreads();
        for (int i = tid; i < 128 * 32; i += 512) { const int s = i >> 5, c8 = (i & 31) * 8; const u32x4 w = *(const u32x4*)(vn + (size_t)(c * 128 + s) * 2048 + h * 256 + c8);
            LAS unsigned* d = (LAS unsigned*)(lds + s * RS + c8 * 2); d[0] = w.x; d[1] = w.y; d[2] = w.z; d[3] = w.w; }
        __syncthreads();
        bf16x8 vf[2][4];
#pragma unroll
        for (int n = 0; n < 2; ++n)
#pragma unroll
            for (int kb = 0; kb < 4; ++kb)
#pragma unroll
                for (int j = 0; j < 8; ++j) vf[n][kb][j] = (short)*(const LAS unsigned short*)(lds + (kb * 32 + fq * 8 + j) * RS + (wid * 32 + n * 16 + fr) * 2);
        for (int tb = 0; tb < 8; ++tb) {
            f32x4 acc[2]; acc[0] = (f32x4){0.f, 0.f, 0.f, 0.f}; acc[1] = acc[0];
            const bf16_t* wrow = was + (size_t)(h * 128 + tb * 16 + fr) * 128 + fq * 8;
#pragma unroll
            for (int kb = 0; kb < 4; ++kb) if (kb <= (tb >> 1)) { const bf16x8 wf = *(const bf16x8*)(wrow + kb * 32);
                acc[0] = __builtin_amdgcn_mfma_f32_16x16x32_bf16(vf[0][kb], wf, acc[0], 0, 0, 0); acc[1] = __builtin_amdgcn_mfma_f32_16x16x32_bf16(vf[1][kb], wf, acc[1], 0, 0, 0); }
            const int row = c * 128 + tb * 16 + fr; const float bs = bsp[h * 128 + tb * 16 + fr];
#pragma unroll
            for (int n = 0; n < 2; ++n) { const int col = h * 256 + wid * 32 + n * 16 + fq * 4; const f32x4 uu = bf4_to_f4(*(const u32x2*)(U + (size_t)row * 2048 + col));
                *(u32x2*)(yb + (size_t)row * 2048 + col) = f4_to_bf4(uu * (acc[n] + bs)); }
        }
    }
}
__device__ __forceinline__ void conv_phase(const Params& p0) {
    const Ctx cx = mkctx(p0); Params p = p0; p.ws = cx.ws; p.out = cx.out;
    const float* Z = (const float*)(p.ws + A_Z); const float* BG = (const float*)(p.ws + A_BG); bf16_t* yc = (bf16_t*)(p.ws + A_YC);
    const float* cw = p.in[37];
    const size_t gt = (size_t)blockIdx.x * 512 + cx.tid, gn = (size_t)gridDim.x * 512;
    for (size_t i = gt; i < (size_t)MT * 256; i += gn) {
        const int row = (int)(i >> 8), c = (int)(i & 255) * 4; int b, t, T; const float* buf; float* cvout;
        if (row < MP) { b = row >> 11; t = row & 2047; T = 2048; buf = nullptr; cvout = p.out + O_CVP + (size_t)b * 2048; }
        else { const int r = row - MP; b = r >> 2; t = r & 3; T = 4; buf = p.in[4] + (size_t)b * 2048; cvout = p.out + O_CVS + (size_t)b * 2048; }
        const f32x4 z0 = *(const f32x4*)(Z + (size_t)row * 1024 + c); const f32x4 zero = (f32x4){0.f, 0.f, 0.f, 0.f};
        const f32x4 z1 = t >= 1 ? *(const f32x4*)(Z + (size_t)(row - 1) * 1024 + c) : (buf ? *(const f32x4*)(buf + 1024 + c) : zero);
        const f32x4 z2 = t >= 2 ? *(const f32x4*)(Z + (size_t)(row - 2) * 1024 + c) : (buf ? *(const f32x4*)(buf + (size_t)t * 1024 + c) : zero);
        const f32x4 cv = *(const f32x4*)(cw + c) * z2 + *(const f32x4*)(cw + 1024 + c) * z1 + *(const f32x4*)(cw + 2048 + c) * z0;
        const f32x4 bg = *(const f32x4*)(BG + (size_t)row * 1024 + c);
        *(u32x2*)(yc + (size_t)row * 1024 + c) = f4_to_bf4(bg * cv);
        if (t >= T - 2) *(f32x4*)(cvout + (size_t)(t - (T - 2)) * 1024 + c) = z0;
    }
}
__device__ __forceinline__ void scan_unit(const Params& p0, LAS unsigned char* lds, int rowbase, int T, int h, const float* s0, float* sout) {
    constexpr int TC = 32, BUF = 6 * TC * 64 * 4 + 256;
    const Ctx cx = mkctx(p0); Params p = p0; p.ws = cx.ws; p.out = cx.out;
    const int tid = cx.tid, wid = tid >> 6, lane = tid & 63, ksg = lane & 15, rl = lane >> 4;
    const int row0 = wid * 8 + rl * 2;
    const float* R = (const float*)(p.ws + A_R); const float* Kp = R + (size_t)MT * 1024; const float* Vp = Kp + (size_t)MT * 1024; const float* DEC = (const float*)(p.ws + A_DEC);
    const bf16_t* AA = (const bf16_t*)(p.ws + A_AA); const bf16_t* GG = (const bf16_t*)(p.ws + A_GG); bf16_t* outp = (bf16_t*)(p.ws + A_OUTPRE);
    LAS float* Y = (LAS float*)(lds + 2 * BUF);
    const int st = tid >> 4, se = (tid & 15) * 4, hc = h * 64 + se;
    const f32x4 kk_w = *(const f32x4*)(p.in[30] + hc), ka_w = *(const f32x4*)(p.in[31] + hc), rk_w = *(const f32x4*)(p.in[32] + hc);
    const f32x4 lg = *(const f32x4*)(p.in[33] + hc), lb = *(const f32x4*)(p.in[34] + hc);
    f32x4 S0, S1;
    if (s0) { S0 = *(const f32x4*)(s0 + (size_t)row0 * 64 + ksg * 4); S1 = *(const f32x4*)(s0 + (size_t)(row0 + 1) * 64 + ksg * 4); }
    else { S0 = (f32x4){0.f, 0.f, 0.f, 0.f}; S1 = S0; }
    f32x4 gr, gk, gv, gd; u32x2 ga;
    const f32x4 zero = (f32x4){0.f, 0.f, 0.f, 0.f};
#define SCAN_LOAD(t0) do { const bool ok_ = (t0) + st < T; const size_t o_ = (size_t)(rowbase + (t0) + st) * 1024 + hc; \
        gr = ok_ ? *(const f32x4*)(R + o_) : zero; gk = ok_ ? *(const f32x4*)(Kp + o_) : zero; gv = ok_ ? *(const f32x4*)(Vp + o_) : zero; gd = ok_ ? *(const f32x4*)(DEC + o_) : zero; \
        ga = ok_ ? *(const u32x2*)(AA + o_) : (u32x2){0u, 0u}; } while (0)
#define SCAN_STORE(bufi) do { LAS float* B_ = (LAS float*)(lds + (bufi) * BUF); const f32x4 a_ = bf4_to_f4(ga); f32x4 kkv = gk * kk_w; \
        float ss_ = (kkv[0] * kkv[0] + kkv[1] * kkv[1]) + (kkv[2] * kkv[2] + kkv[3] * kkv[3]); ss_ = red16(ss_); \
        const float inv_ = 1.0f / fmaxf(sqrtf(ss_), 1e-12f); kkv = kkv * inv_; \
        const f32x4 km_ = gk * ((a_ - 1.0f) * ka_w + 1.0f); const f32x4 rb_ = gr * km_ * rk_w; float bs_ = (rb_[0] + rb_[1]) + (rb_[2] + rb_[3]); bs_ = red16(bs_); \
        const int o_ = st * 64 + se; *(LAS f32x4*)(B_ + o_) = gd; *(LAS f32x4*)(B_ + 2048 + o_) = kkv; *(LAS f32x4*)(B_ + 4096 + o_) = kkv * a_; \
        *(LAS f32x4*)(B_ + 6144 + o_) = km_; *(LAS f32x4*)(B_ + 8192 + o_) = gr; *(LAS f32x4*)(B_ + 10240 + o_) = gv; if ((tid & 15) == 0) B_[12288 + st] = bs_; } while (0)
    __syncthreads();
    SCAN_LOAD(0); SCAN_STORE(0);
    __syncthreads();
    const int nch = (T + TC - 1) / TC;
    for (int c = 0; c < nch; ++c) {
        const int t0 = c * TC; const int nst = (T - t0) < TC ? (T - t0) : TC;
        if (c + 1 < nch) SCAN_LOAD(t0 + TC);
        const LAS float* B = (const LAS float*)(lds + (c & 1) * BUF);
        for (int tt = 0; tt < nst; ++tt) {
            const f32x4 w = *(const LAS f32x4*)(B + tt * 64 + ksg * 4), kk = *(const LAS f32x4*)(B + 2048 + tt * 64 + ksg * 4), ka = *(const LAS f32x4*)(B + 4096 + tt * 64 + ksg * 4);
            const f32x4 km = *(const LAS f32x4*)(B + 6144 + tt * 64 + ksg * 4), rr = *(const LAS f32x4*)(B + 8192 + tt * 64 + ksg * 4);
            const f32x2 vv = *(const LAS f32x2*)(B + 10240 + tt * 64 + row0);
            float p0 = (S0[0] * kk[0] + S0[1] * kk[1]) + (S0[2] * kk[2] + S0[3] * kk[3]);
            float p1 = (S1[0] * kk[0] + S1[1] * kk[1]) + (S1[2] * kk[2] + S1[3] * kk[3]);
            p0 = red16(p0); p1 = red16(p1);
            S0 = S0 * w - ka * p0 + km * vv.x;
            S1 = S1 * w - ka * p1 + km * vv.y;
            float q0 = (S0[0] * rr[0] + S0[1] * rr[1]) + (S0[2] * rr[2] + S0[3] * rr[3]);
            float q1 = (S1[0] * rr[0] + S1[1] * rr[1]) + (S1[2] * rr[2] + S1[3] * rr[3]);
            q0 = red16(q0); q1 = red16(q1);
            if (ksg == 0) *(LAS f32x2*)(Y + tt * 64 + row0) = (f32x2){q0, q1};
        }
        __syncthreads();
        if (st < nst) {
            const f32x4 y = *(const LAS f32x4*)(Y + st * 64 + se); const f32x4 v4 = *(const LAS f32x4*)(B + 10240 + st * 64 + se); const float bs = B[12288 + st];
            float s = (y[0] + y[1]) + (y[2] + y[3]); s = red16(s); const float mean = s * (1.0f / 64.0f);
            const f32x4 d = y - mean; float q = (d[0] * d[0] + d[1] * d[1]) + (d[2] * d[2] + d[3] * d[3]); q = red16(q);
            const float rstd = rsqrtf(q * (1.0f / 64.0f) + 64e-5f);
            const size_t o = (size_t)(rowbase + t0 + st) * 1024 + hc;
            const f32x4 g4 = bf4_to_f4(*(const u32x2*)(GG + o));
            *(u32x2*)(outp + o) = f4_to_bf4((d * rstd * lg + lb + v4 * bs) * g4);
        } else { float s = 0.f; s = red16(s); s = red16(s); (void)s; }
        if (c + 1 < nch) SCAN_STORE((c + 1) & 1);
        __syncthreads();
    }
    *(f32x4*)(sout + (size_t)row0 * 64 + ksg * 4) = S0; *(f32x4*)(sout + (size_t)(row0 + 1) * 64 + ksg * 4) = S1;
#undef SCAN_LOAD
#undef SCAN_STORE
}
__device__ __forceinline__ void scan_phase(const Params& p, LAS unsigned char* lds) {
    const int G = gridDim.x, c = blockIdx.x;
    if (c < 128 || G <= 128) {
        for (int u = c; u < 128; u += G) { const int b = u >> 4, h = u & 15; scan_unit(p, lds, b * 2048, 2048, h, nullptr, p.out + O_WKVP + (size_t)u * 4096); }
    }
    const int ns = G > 128 ? G - 128 : G, cs = G > 128 ? c - 128 : c;
    if (cs >= 0) for (int u = cs; u < 2048; u += ns) { const int b = u >> 4, h = u & 15; scan_unit(p, lds, MP + b * 4, 4, h, p.in[2] + (size_t)u * 4096, p.out + O_WKVS + (size_t)u * 4096); }
}

#define XB_TMO      128
#define XB_XCNT(j)  (256  + 64 * (j))
#define XB_XSUB(j)  (1280 + 64 * (j))
#define XB_XGEN(j)  (2304 + 64 * (j))
#define XB_TOP      3328
#define XB_TOPGEN   3392
#define XCD_BAR_WORDS 3456
#define XB_SPIN_CAP (1u << 18)

__device__ __forceinline__ unsigned xb_ld(unsigned* p)              { return __hip_atomic_load(p, __ATOMIC_RELAXED, __HIP_MEMORY_SCOPE_AGENT); }
__device__ __forceinline__ unsigned xb_add(unsigned* p, unsigned v) { return __hip_atomic_fetch_add(p, v, __ATOMIC_RELAXED, __HIP_MEMORY_SCOPE_AGENT); }
__device__ __forceinline__ unsigned xb_xcc_id() { return (unsigned)__builtin_amdgcn_s_getreg((3 << 11) | 20) & 0xFu; }
#define XB_SPIN(cond, bar) do { unsigned _sp = 0; while (cond) { __builtin_amdgcn_s_sleep(1); \
    if ((++_sp & 255u) == 0u) { if (xb_ld(&(bar)[XB_TMO])) break; if (_sp > XB_SPIN_CAP) { atomicAdd(&(bar)[XB_TMO], 1u); break; } } } } while (0)

struct XcdBarrier {
    unsigned* bar; unsigned x;
    volatile LAS unsigned* st;
};

__device__ __forceinline__ XcdBarrier xcd_barrier_post(unsigned* bar, volatile LAS unsigned* st) {
    XcdBarrier b; b.bar = bar; b.x = xb_xcc_id(); b.st = st;
    if (threadIdx.x == 0) (void)xb_add(&bar[XB_XCNT(b.x)], 1u);
    return b;
}
__device__ __forceinline__ void xcd_barrier_complete(unsigned* bar, unsigned x, unsigned& nloc, unsigned& nx) {
    const unsigned G = gridDim.x * gridDim.y * gridDim.z;
    unsigned sum, cnt, mine, sp = 0u;
    for (;;) {
        sum = 0u; cnt = 0u; mine = 0u;
#pragma unroll
        for (unsigned j = 0; j < 16; ++j) { const unsigned c = xb_ld(&bar[XB_XCNT(j)]); sum += c; cnt += (c > 0u) ? 1u : 0u; mine = (j == x) ? c : mine; }
        if (sum == G) break;
        __builtin_amdgcn_s_sleep(1);
        if ((++sp & 255u) == 0u) { if (xb_ld(&bar[XB_TMO])) break; if (sp > XB_SPIN_CAP) { atomicAdd(&bar[XB_TMO], 1u); break; } }
    }
    nloc = mine > 0u ? mine : 1u; nx = cnt > 0u ? cnt : 1u;
}

__device__ __forceinline__ void xcd_barrier(const XcdBarrier& b) {
    asm volatile("s_waitcnt vmcnt(0)" ::: "memory");
    __syncthreads();
    if (threadIdx.x == 0) {
        unsigned* bar = b.bar;
        __builtin_amdgcn_s_waitcnt(0);
        unsigned nloc = b.st[0], nx = b.st[1];
        if (nloc == 0u) { xcd_barrier_complete(bar, b.x, nloc, nx); b.st[0] = nloc; b.st[1] = nx; }
        const unsigned old = xb_add(&bar[XB_XSUB(b.x)], 1u);
        const unsigned gen = old / nloc;
        if (old + 1u == (gen + 1u) * nloc) {
            __builtin_amdgcn_fence(__ATOMIC_RELEASE, "agent");
            asm volatile("s_waitcnt vmcnt(0)" ::: "memory");
            const unsigned og = xb_add(&bar[XB_TOP], 1u);
            const unsigned tg = og / nx;
            if (og + 1u == (tg + 1u) * nx) xb_add(&bar[XB_TOPGEN], 1u);
            else XB_SPIN(xb_ld(&bar[XB_TOPGEN]) == tg, bar);
            __builtin_amdgcn_fence(__ATOMIC_ACQUIRE, "agent");
            xb_add(&bar[XB_XGEN(b.x)], 1u);
            asm volatile("s_waitcnt vmcnt(0)" ::: "memory");
        } else {
            XB_SPIN(xb_ld(&bar[XB_XGEN(b.x)]) == gen, bar);
            __builtin_amdgcn_fence(__ATOMIC_ACQUIRE, "agent");
            asm volatile("s_waitcnt vmcnt(0)" ::: "memory");
        }
    }
    __syncthreads();
}


enum { PT_PREP = 0, PT_GEMM, PT_LN, PT_SHIFT, PT_LNV, PT_SPATIAL, PT_CONV, PT_SCAN };
struct Phase { int type; int ng; int a0, a1, a2; GemmDesc g[2]; };

__device__ __forceinline__ GemmDesc mk(const void* A, int lda, const void* Bt, int ldb, int K, int N, int kind, float* f0, void* h0, void* h1, const float* c0, const float* c1, float scale, int ld) {
    GemmDesc g; g.A = (const bf16_t*)A; g.Bt = (const bf16_t*)Bt; g.lda = lda; g.ldb = ldb; g.K = K; g.nN = N / 256;
    g.e.kind = kind; g.e.f0 = f0; g.e.h0 = (bf16_t*)h0; g.e.h1 = (bf16_t*)h1; g.e.c0 = c0; g.e.c1 = c1; g.e.scale = scale; g.e.ld = ld; return g; }

__device__ __forceinline__ void build_phase(const Params& p, int ph, Phase& P) {
    unsigned char* ws = p.ws; float* X = p.out + O_Y;
    P.ng = 0; P.a0 = P.a1 = P.a2 = 0; P.type = PT_PREP;
    if (ph == 0) return;
    int q = ph - 1, layer, step;
    if (q < 12) { layer = 0; step = q; } else if (q < 25) { layer = 1; step = q - 12; } else if (q < 36) { layer = 2; step = q - 25; } else { layer = 3; step = q - 36; }
    const int kind = layer % 3, j = layer / 3;
    const int nmix = kind == 0 ? 4 : (kind == 1 ? 5 : 3);
    const bf16_t* ffn_in0 = (const bf16_t*)(ws + W_FFN_IN) + (size_t)(layer * 2) * 5632 * 1024;
    const bf16_t* ffn_out0 = (const bf16_t*)(ws + W_FFN_OUT) + (size_t)(layer * 2) * 1024 * 2816;
    if (step == 0) { P.type = PT_GEMM; P.ng = 1; P.g[0] = mk(ws + A_XBALT, 1024, ffn_in0, 1024, 1024, 5632, EK_FFN1, nullptr, ws + A_ACT, nullptr, nullptr, nullptr, 0.f, 0); return; }
    if (step == 1) { P.type = PT_GEMM; P.ng = 1; P.g[0] = mk(ws + A_ACT, DFF, ffn_out0, DFF, DFF, 1024, EK_RES, X, nullptr, nullptr, nullptr, nullptr, 0.5f, 0); return; }
    if (step == 2) { P.type = PT_LN; P.a0 = layer; P.a1 = 0; P.a2 = 0; return; }
    const int ms = step - 3;
    if (ms < nmix) {
        if (kind == 0) {
            if (ms == 0) { P.type = PT_GEMM; P.ng = 1; P.g[0] = mk(ws + A_XB, 1024, (const bf16_t*)(ws + W_A_IN) + (size_t)j * 4096 * 1024, 1024, 1024, 4096, EK_GELU_UV, (float*)(ws + A_V), ws + A_U, nullptr, p.in[14] + (size_t)j * 4096, nullptr, 0.f, 0); return; }
            if (ms == 1) { P.type = PT_LNV; P.a0 = j; return; }
            if (ms == 2) { P.type = PT_SPATIAL; P.a0 = j; return; }
            P.type = PT_GEMM; P.ng = 1; P.g[0] = mk(ws + A_YB, 2048, (const bf16_t*)(ws + W_A_OUT) + (size_t)j * 1024 * 2048, 2048, 2048, 1024, EK_RES, X, nullptr, nullptr, nullptr, nullptr, 1.0f, 0); return;
        } else if (kind == 1) {
            if (ms == 0) { P.type = PT_SHIFT; return; }
            if (ms == 1) { P.type = PT_GEMM; P.ng = 1; P.g[0] = mk(ws + A_XCAT, 2048, ws + W_B_IN, 2048, 2048, 3328, EK_BIN, (float*)(ws + A_R), ws + A_T, nullptr, nullptr, nullptr, 0.f, 0); return; }
            if (ms == 2) { P.type = PT_GEMM; P.ng = 1; P.g[0] = mk(ws + A_T, 256, ws + W_B_L2, 256, 256, 3072, EK_BL2, (float*)(ws + A_DEC), ws + A_AA, ws + A_GG, p.in[22], p.in[25], 0.f, 0); return; }
            if (ms == 3) { P.type = PT_SCAN; return; }
            P.type = PT_GEMM; P.ng = 1; P.g[0] = mk(ws + A_OUTPRE, 1024, ws + W_B_O, 1024, 1024, 1024, EK_RES, X, nullptr, nullptr, nullptr, nullptr, 1.0f, 0); return;
        } else {
            if (ms == 0) { P.type = PT_GEMM; P.ng = 2;
                P.g[0] = mk(ws + A_XB, 1024, ws + W_C_IN, 1024, 1024, 2048, EK_CONVZ, (float*)(ws + A_Z), nullptr, nullptr, nullptr, nullptr, 0.f, 0);
                P.g[1] = mk(ws + A_XB, 1024, (const bf16_t*)(ws + W_C_IN) + (size_t)2048 * 1024, 1024, 1024, 1024, EK_STORE, (float*)(ws + A_BG), nullptr, nullptr, nullptr, nullptr, 0.f, 1024); return; }
            if (ms == 1) { P.type = PT_CONV; return; }
            P.type = PT_GEMM; P.ng = 1; P.g[0] = mk(ws + A_YC, 1024, ws + W_C_OUT, 1024, 1024, 1024, EK_RES, X, nullptr, nullptr, nullptr, nullptr, 1.0f, 0); return;
        }
    }
    const int ts = ms - nmix;
    if (ts == 0) { P.type = PT_LN; P.a0 = layer; P.a1 = 1; P.a2 = 1; return; }
    if (ts == 1) { P.type = PT_GEMM; P.ng = 2;
        P.g[0] = mk(ws + A_XB, 1024, ffn_in0 + (size_t)5632 * 1024, 1024, 1024, 5632, EK_FFN1, nullptr, ws + A_ACT, nullptr, nullptr, nullptr, 0.f, 0);
        P.g[1] = mk(ws + A_PB, 256, (const bf16_t*)(ws + W_PLE_P) + (size_t)layer * 1024 * 256, 256, 256, 1024, EK_STORE, (float*)(ws + A_PP), nullptr, nullptr, nullptr, nullptr, 0.f, 1024); return; }
    if (ts == 2) { P.type = PT_GEMM; P.ng = 1; P.g[0] = mk(ws + A_ACT, DFF, ffn_out0 + (size_t)1024 * 2816, DFF, DFF, 1024, EK_RES, X, nullptr, nullptr, nullptr, nullptr, 0.5f, 0); return; }
    if (ts == 3) { P.type = PT_LN; P.a0 = layer; P.a1 = 2; P.a2 = 0; return; }
    P.type = PT_GEMM; P.ng = 1; P.g[0] = mk(ws + A_XB, 1024, (const bf16_t*)(ws + W_PLE_G) + (size_t)layer * 1024 * 1024, 1024, 1024, 1024, EK_PLE, X, ws + A_XBALT, nullptr, (const float*)(ws + A_PP), nullptr, 0.f, 0);
}
constexpr int NPHASES = 1 + 12 + 13 + 11 + 12;
#ifndef PROBE_MASK
#define PROBE_MASK 0
#endif

__global__ void __launch_bounds__(512) fwd_megakernel(Params p) {
    extern __shared__ __attribute__((aligned(16))) unsigned char lds_raw[];
    LAS unsigned char* lds = (LAS unsigned char*)lds_raw;
    cg::grid_group grid = cg::this_grid();
    Phase* tab = (Phase*)(p.ws + A_TAB);
    __shared__ uint4 xb_words;
    unsigned* barw = (unsigned*)(p.ws + A_BAR);
    if (threadIdx.x == 0) xb_words = make_uint4(0u, 0u, 0u, 0u);
    if (blockIdx.x == 0) for (int i = threadIdx.x; i < XCD_BAR_WORDS; i += 512) barw[i] = 0u;
    __syncthreads();
    if (blockIdx.x == 0 && threadIdx.x < NPHASES) build_phase(p, threadIdx.x, tab[threadIdx.x]);
    for (int rep = 0; rep < ((PROBE_MASK & 4) ? 2 : 1); ++rep) { prep_phase(p, lds); grid.sync(); }
    const XcdBarrier xb = xcd_barrier_post(barw, (volatile LAS unsigned*)&xb_words);
    for (int ph = 1; ph < NPHASES; ++ph) {
        const Phase* P = tab + ph;
        const int type = uload32(&P->type);
        int nrep = 1;
        if (PROBE_MASK & 1) { if (type == PT_GEMM && uload32(&P->g[0].e.kind) == EK_FFN1) nrep = 2; }
        if (PROBE_MASK & 2) { if (type == PT_SCAN) nrep = 2; }
        if (PROBE_MASK & 16) { if (type == PT_LNV || type == PT_SPATIAL) nrep = 2; }
        if (PROBE_MASK & 32) { if (type == PT_SHIFT || type == PT_CONV) nrep = 2; }
        for (int rep = 0; rep < nrep; ++rep) {
        if (PROBE_MASK & 8) xcd_barrier(xb);
        switch (type) {
            case PT_GEMM: { const int ng = uload32(&P->ng); for (int gi = 0; gi < ng; ++gi) { const GemmDesc* g = &P->g[gi]; if (!((PROBE_MASK & 128) && rep == 1)) gemm_big(lds, g, !((PROBE_MASK & 256) && rep == 1)); if (!((PROBE_MASK & 64) && rep == 1)) gemm_small(lds, g); } } break;
            case PT_LN: ln_phase(p, uload32(&P->a0), uload32(&P->a1), uload32(&P->a2) != 0); break;
            case PT_SHIFT: shift_phase(p); break;
            case PT_LNV: lnv_phase(p, uload32(&P->a0)); break;
            case PT_SPATIAL: spatial_phase(p, uload32(&P->a0), lds); break;
            case PT_CONV: conv_phase(p); break;
            default: scan_phase(p, lds); break;
        }
        if (ph + 1 < NPHASES || rep + 1 < nrep) xcd_barrier(xb);
        }
    }
}

extern "C" void kernel_launch(void* const* d_in, const int* in_sizes, int n_in, void* d_out, int out_size, void* d_ws, size_t ws_size, hipStream_t stream) {
    static int grid_blocks = 0;
    if (grid_blocks == 0) {
        if (n_in != 39 || ws_size < WS_END) { fprintf(stderr, "kernel_launch: need 39 inputs and %zu bytes of workspace, got %d / %zu\n", (size_t)WS_END, n_in, ws_size); grid_blocks = -1; return; }
        int dev = 0, cus = 0, per_cu = 0;
        hipGetDevice(&dev); hipDeviceGetAttribute(&cus, hipDeviceAttributeMultiprocessorCount, dev);
        if (hipFuncSetAttribute((const void*)fwd_megakernel, hipFuncAttributeMaxDynamicSharedMemorySize, LDS_BYTES) != hipSuccess) { fprintf(stderr, "kernel_launch: hipFuncSetAttribute failed\n"); grid_blocks = -1; return; }
        hipOccupancyMaxActiveBlocksPerMultiprocessor(&per_cu, (const void*)fwd_megakernel, 512, LDS_BYTES);
        if (per_cu < 1) { fprintf(stderr, "kernel_launch: occupancy query says %d blocks per CU\n", per_cu); per_cu = 1; }
        (void)hipGetLastError();
        grid_blocks = cus;
    }
    if (grid_blocks < 0) return;
    Params p{};
    for (int i = 0; i < 39; ++i) p.in[i] = (const float*)d_in[i];
    p.out = (float*)d_out; p.ws = (unsigned char*)d_ws;
    void* args[] = {&p};
    hipError_t e = hipLaunchCooperativeKernel((const void*)fwd_megakernel, dim3(grid_blocks), dim3(512), args, LDS_BYTES, stream);
    if (e != hipSuccess) fprintf(stderr, "cooperative launch failed: %s (grid %d)\n", hipGetErrorString(e), grid_blocks);
}
```

```cpp
#include <hip/hip_runtime.h>
#include <hip/hip_cooperative_groups.h>
#include <cstdio>
namespace cg = cooperative_groups;

#define LAS __attribute__((address_space(3)))
#define GAS __attribute__((address_space(1)))
typedef unsigned short bf16_t;
typedef short bf16x8 __attribute__((ext_vector_type(8)));
typedef float f32x4 __attribute__((ext_vector_type(4)));
typedef float f32x2 __attribute__((ext_vector_type(2)));
typedef unsigned u32x4 __attribute__((ext_vector_type(4)));
typedef unsigned u32x2 __attribute__((ext_vector_type(2)));

constexpr int D = 1024, MP = 16384, MS = 512, MT = MP + MS, DFF = 2816;
constexpr float ALPHA = 1.6817928305074290f;
constexpr int BM = 256, BK = 64, HALF = 128, HTB = HALF * BK * 2, STAGE_BYTES = 8 * HTB, NXCD = 8, WGM = 8;
constexpr int LDS_BYTES = STAGE_BYTES;

constexpr size_t SZ_ROWF = (size_t)MT * 1024 * 4;
constexpr size_t W_FFN_IN = 0;
constexpr size_t W_FFN_OUT = W_FFN_IN + (size_t)8 * 5632 * 1024 * 2;
constexpr size_t W_PLE_G = W_FFN_OUT + (size_t)8 * 1024 * 2816 * 2;
constexpr size_t W_PLE_P = W_PLE_G + (size_t)4 * 1024 * 1024 * 2;
constexpr size_t W_A_IN = W_PLE_P + (size_t)4 * 1024 * 256 * 2;
constexpr size_t W_A_OUT = W_A_IN + (size_t)2 * 4096 * 1024 * 2;
constexpr size_t W_A_S = W_A_OUT + (size_t)2 * 1024 * 2048 * 2;
constexpr size_t W_B_IN = W_A_S + (size_t)2 * 8 * 128 * 128 * 2;
constexpr size_t W_B_L2 = W_B_IN + (size_t)3328 * 2048 * 2;
constexpr size_t W_B_O = W_B_L2 + (size_t)3072 * 256 * 2;
constexpr size_t W_C_IN = W_B_O + (size_t)1024 * 1024 * 2;
constexpr size_t W_C_OUT = W_C_IN + (size_t)3072 * 1024 * 2;
constexpr size_t A_XB = W_C_OUT + (size_t)1024 * 1024 * 2;
constexpr size_t A_ACT = A_XB + (size_t)MT * 1024 * 2;
constexpr size_t A_PB = A_ACT + (size_t)MT * 2816 * 2;
constexpr size_t A_PP = A_PB + (size_t)MT * 256 * 2;
constexpr size_t A_MIX = A_PP + SZ_ROWF;
constexpr size_t A_TAB = A_MIX + 4 * SZ_ROWF;
constexpr size_t A_BAR = A_TAB + 65536;
constexpr size_t WS_END = A_BAR + 16384;
constexpr size_t A_XBALT = A_MIX;
constexpr size_t A_U = A_MIX, A_V = A_MIX + (size_t)MT * 2048 * 2, A_VN = A_V + (size_t)MT * 2048 * 4, A_YB = A_ACT;
constexpr size_t A_R = A_MIX, A_DEC = A_MIX + 3 * SZ_ROWF, A_AA = A_ACT, A_GG = A_ACT + (size_t)MT * 1024 * 2, A_T = A_GG + (size_t)MT * 1024 * 2;
constexpr size_t A_XCAT = A_PP, A_OUTPRE = A_PP;
constexpr size_t A_Z = A_MIX, A_BG = A_MIX + SZ_ROWF, A_YC = A_ACT;
static_assert(A_VN + (size_t)MP * 2048 * 2 <= WS_END, "mix region");

constexpr size_t O_Y = 0, O_AV = (size_t)MT * 1024, O_WKVP = O_AV + (size_t)2 * 512 * 2048, O_SHP = O_WKVP + 524288, O_CVP = O_SHP + 8192,
                 O_WKVS = O_CVP + 16384, O_SHS = O_WKVS + 8388608, O_CVS = O_SHS + 131072;

struct Params { const float* in[39]; float* out; unsigned char* ws; };
struct Ctx { int tid; unsigned char* ws; float* out; };
__device__ __forceinline__ Ctx mkctx(const Params& p) { Ctx c; c.tid = threadIdx.x; size_t z = 0; asm volatile("" : "+v"(c.tid)); asm volatile("" : "+s"(z)); c.ws = p.ws + z; c.out = p.out + z; return c; }
__device__ __forceinline__ int uload32(const void* p) { return __builtin_amdgcn_readfirstlane(*(const volatile int*)p); }
template <class T> __device__ __forceinline__ T* uloadp(const void* p) { const unsigned lo = (unsigned)uload32(p), hi = (unsigned)uload32((const char*)p + 4); return (T*)(((unsigned long long)hi << 32) | lo); }

__device__ __forceinline__ unsigned cvt_pk_bf16(float lo, float hi) { unsigned r; asm("v_cvt_pk_bf16_f32 %0, %1, %2" : "=v"(r) : "v"(lo), "v"(hi)); return r; }
__device__ __forceinline__ float bf2f(unsigned short b) { return __uint_as_float(((unsigned)b) << 16); }
__device__ __forceinline__ f32x4 bf4_to_f4(u32x2 w) { return (f32x4){__uint_as_float(w.x << 16), __uint_as_float(w.x & 0xffff0000u), __uint_as_float(w.y << 16), __uint_as_float(w.y & 0xffff0000u)}; }
__device__ __forceinline__ u32x2 f4_to_bf4(f32x4 v) { u32x2 w; w.x = cvt_pk_bf16(v[0], v[1]); w.y = cvt_pk_bf16(v[2], v[3]); return w; }
__device__ __forceinline__ float wave_sum(float v) {
#pragma unroll
    for (int o = 32; o >= 1; o >>= 1) v += __shfl_xor(v, o);
    return v; }
template <int CTRL> __device__ __forceinline__ float dppmov(float v) { return __int_as_float(__builtin_amdgcn_update_dpp(0, __float_as_int(v), CTRL, 0xF, 0xF, true)); }
__device__ __forceinline__ float red16(float v) { v += dppmov<0xB1>(v); v += dppmov<0x4E>(v); v += dppmov<0x141>(v); v += dppmov<0x140>(v); return v; }
__device__ __forceinline__ float sigmoidf_(float x) { return 1.0f / (1.0f + __expf(-x)); }
__device__ __forceinline__ float tanh_(float x) { const float e = __expf(-2.0f * fabsf(x)); const float t = (1.0f - e) / (1.0f + e); return x < 0.f ? -t : t; }
__device__ __forceinline__ float decay_(float w) { const float sp = fmaxf(-w, 0.f) + __logf(1.0f + __expf(-fabsf(w))); return __expf(-__expf(-sp - 0.5f)); }
__device__ __forceinline__ f32x2 gelu_pk(f32x2 v) {
    const f32x2 av = __builtin_elementwise_abs(v), d = av * 0.2316418882f + 1.0f;
    f32x2 t; t.x = __builtin_amdgcn_rcpf(d.x); t.y = __builtin_amdgcn_rcpf(d.y);
    f32x2 q = t * 0.5307027145f + (-0.7265760135f); q = q * t + 0.7107068705f; q = q * t + (-0.142248368f); q = q * t + 0.127414796f; q = q * t;
    const f32x2 s = (v * v) * (-0.72134752044f);
    f32x2 e; e.x = __builtin_amdgcn_exp2f(s.x); e.y = __builtin_amdgcn_exp2f(s.y);
    const f32x2 m = v * (q * e), r = v - m;
    f32x2 o; o.x = v.x < 0.f ? m.x : r.x; o.y = v.y < 0.f ? m.y : r.y; return o;
}
__device__ __forceinline__ f32x4 gelu4(f32x4 v) { f32x2 a = gelu_pk((f32x2){v[0], v[1]}), b = gelu_pk((f32x2){v[2], v[3]}); return (f32x4){a.x, a.y, b.x, b.y}; }

enum { EK_FFN1 = 0, EK_RES, EK_GELU_UV, EK_STORE, EK_CONVZ, EK_PLE, EK_BIN, EK_BL2 };
struct alignas(16) GemmDesc {
    const bf16_t* A; const bf16_t* Bt;
    int lda, ldb, K, nN;
    int kind, nM, ld; float scale;
    float* f0; bf16_t* h0;
    bf16_t* h1; const float* c0;
    const float* c1; long long pad;
};
struct EpiG { int kind; GAS float* f0; GAS bf16_t* h0; GAS bf16_t* h1; const GAS float* c0; const GAS float* c1; float scale; int ld; };
__device__ __forceinline__ void uload_x4(const GAS u32x4* p, unsigned (&o)[4]) { const u32x4 v = *p; o[0] = (unsigned)__builtin_amdgcn_readfirstlane((int)v.x); o[1] = (unsigned)__builtin_amdgcn_readfirstlane((int)v.y); o[2] = (unsigned)__builtin_amdgcn_readfirstlane((int)v.z); o[3] = (unsigned)__builtin_amdgcn_readfirstlane((int)v.w); }
__device__ __forceinline__ unsigned long long mk64(unsigned lo, unsigned hi) { return ((unsigned long long)hi << 32) | lo; }
struct GemmHead { const GAS bf16_t* A; const GAS bf16_t* Bt; int lda, ldb, K, nN, kind, nM; };
__device__ __forceinline__ GemmHead load_head(const GemmDesc* gd) {
    const GemmDesc* g2 = gd; asm volatile("" : "+s"(g2)); const GAS u32x4* q = (const GAS u32x4*)g2; unsigned a[4], b[4], c[4]; uload_x4(q, a); uload_x4(q + 1, b); uload_x4(q + 2, c);
    GemmHead h; h.A = (const GAS bf16_t*)mk64(a[0], a[1]); h.Bt = (const GAS bf16_t*)mk64(a[2], a[3]); h.lda = (int)b[0]; h.ldb = (int)b[1]; h.K = (int)b[2]; h.nN = (int)b[3]; h.kind = (int)c[0]; h.nM = (int)c[1]; return h; }
__device__ __forceinline__ EpiG load_epi(const GemmDesc* gd) {
    const GemmDesc* g2 = gd; asm volatile("" : "+s"(g2)); const GAS u32x4* q = (const GAS u32x4*)g2; unsigned c[4], d[4], e4[4], f[4]; uload_x4(q + 2, c); uload_x4(q + 3, d); uload_x4(q + 4, e4); uload_x4(q + 5, f);
    EpiG e; e.kind = (int)c[0]; e.ld = (int)c[2]; e.scale = __uint_as_float(c[3]); e.f0 = (GAS float*)mk64(d[0], d[1]); e.h0 = (GAS bf16_t*)mk64(d[2], d[3]); e.h1 = (GAS bf16_t*)mk64(e4[0], e4[1]);
    e.c0 = (const GAS float*)mk64(e4[2], e4[3]); e.c1 = (const GAS float*)mk64(f[0], f[1]); return e; }

template <int KIND> __device__ __forceinline__ void epi_elem(const EpiG& e, int row, int col, f32x4 v0, f32x4 v1) {
    if (KIND == EK_FFN1) {
        f32x4 o;
#pragma unroll
        for (int j = 0; j < 4; ++j) o[j] = v0[j] * __builtin_amdgcn_rcpf(1.0f + __expf(-v0[j])) * v1[j];
        *(GAS u32x2*)(e.h0 + (size_t)row * DFF + col) = f4_to_bf4(o);
    } else if (KIND == EK_RES) {
        GAS float* p = e.f0 + (size_t)row * 1024 + col; const f32x4 x = *(const f32x4*)p; *(f32x4*)p = x * ALPHA + v0 * e.scale;
    } else if (KIND == EK_GELU_UV) {
        const f32x4 b = *(const GAS f32x4*)(e.c0 + col); const f32x4 g = gelu4(v0 + b);
        if (col < 2048) *(GAS u32x2*)(e.h0 + (size_t)row * 2048 + col) = f4_to_bf4(g);
        else *(GAS f32x4*)(e.f0 + (size_t)row * 2048 + (col - 2048)) = g;
    } else if (KIND == EK_STORE) {
        *(GAS f32x4*)(e.f0 + (size_t)row * e.ld + col) = v0;
    } else if (KIND == EK_CONVZ) {
        *(GAS f32x4*)(e.f0 + (size_t)row * 1024 + col) = v0 * v1;
    } else if (KIND == EK_PLE) {
        GAS float* p = e.f0 + (size_t)row * 1024 + col; f32x4 x = *(const f32x4*)p; const f32x4 pp = *(const GAS f32x4*)(e.c0 + (size_t)row * 1024 + col);
#pragma unroll
        for (int j = 0; j < 4; ++j) x[j] += pp[j] * __builtin_amdgcn_rcpf(1.0f + __expf(-v0[j]));
        *(f32x4*)p = x; *(GAS u32x2*)(e.h0 + (size_t)row * 1024 + col) = f4_to_bf4(x);
    } else if (KIND == EK_BIN) {
        if (col < 3072) { const int t = col >> 10; *(GAS f32x4*)(e.f0 + (size_t)t * ((size_t)MT * 1024) + (size_t)row * 1024 + (col & 1023)) = v0; }
        else { const int c = col - 3072; f32x4 o;
            if (c < 64) { o[0] = tanh_(v0[0]); o[1] = tanh_(v0[1]); o[2] = tanh_(v0[2]); o[3] = tanh_(v0[3]); }
            else if (c < 128) o = v0;
            else { o[0] = sigmoidf_(v0[0]); o[1] = sigmoidf_(v0[1]); o[2] = sigmoidf_(v0[2]); o[3] = sigmoidf_(v0[3]); }
            *(GAS u32x2*)(e.h0 + (size_t)row * 256 + c) = f4_to_bf4(o); }
    } else if (KIND == EK_BL2) {
        if (col < 1024) { const f32x4 w0 = *(const GAS f32x4*)(e.c0 + col); f32x4 o;
#pragma unroll
            for (int j = 0; j < 4; ++j) o[j] = decay_(w0[j] + v0[j]);
            *(GAS f32x4*)(e.f0 + (size_t)row * 1024 + col) = o;
        } else if (col < 2048) { const int c = col - 1024; const f32x4 a0 = *(const GAS f32x4*)(e.c1 + c); f32x4 o;
#pragma unroll
            for (int j = 0; j < 4; ++j) o[j] = sigmoidf_(a0[j] + v0[j]);
            *(GAS u32x2*)(e.h0 + (size_t)row * 1024 + c) = f4_to_bf4(o);
        } else { *(GAS u32x2*)(e.h1 + (size_t)row * 1024 + (col - 2048)) = f4_to_bf4(v0); }
    }
}
template <int KIND> __device__ __forceinline__ void epi_big(const GemmDesc* gd, const f32x4 (&acc)[2][2][4][2], int pm, int pn, int wr, int wc, int fr, int fq) {
    constexpr bool PAIRED = (KIND == EK_FFN1 || KIND == EK_CONVZ);
    const EpiG e = load_epi(gd);
#pragma unroll
    for (int ai = 0; ai < 2; ++ai)
#pragma unroll
        for (int m = 0; m < 4; ++m) {
            if (m & 1) asm volatile("" ::: "memory");
            const int row = pm * BM + ai * HALF + wr * 64 + m * 16 + fr;
#pragma unroll
            for (int n = 0; n < 2; ++n) {
                if (PAIRED) epi_elem<KIND>(e, row, pn * 128 + wc * 32 + n * 16 + fq * 4, acc[ai][0][m][n], acc[ai][1][m][n]);
                else {
#pragma unroll
                    for (int bj = 0; bj < 2; ++bj) epi_elem<KIND>(e, row, pn * BM + bj * HALF + wc * 32 + n * 16 + fq * 4, acc[ai][bj][m][n], acc[ai][bj][m][n]);
                }
            }
        }
}

__device__ __forceinline__ int lds_byte(int r, int c) { const int st = (r >> 4) * 2 + (c >> 5), rr = r & 15, cc = c & 31, ob = rr * 64 + cc * 2; return st * 1024 + (ob ^ (((ob >> 9) & 1) << 5)); }
__device__ __forceinline__ void stage_rc(int b, int& R, int& C) { const int st = b / 1024, sb = b % 1024, swz = sb ^ (((sb >> 9) & 1) << 5); R = (st >> 1) * 16 + swz / 64; C = (st & 1) * 32 + (swz % 64) / 2; }
struct Unit { int pm, pn; };
struct StaticOrder {
    int nM, nN, nwg, G, c;
    __device__ void init(int nM_, int nN_, int G_, int c_) { nM = nM_; nN = nN_; nwg = nM * nN; G = G_; c = c_; }
    __device__ bool next(int i, Unit& u) const {
        const long L = (long)i * G + c; if (L >= nwg) return false;
        int wgid = (int)L; { const int q = nwg / NXCD, r = nwg % NXCD, xcd = wgid % NXCD, off = wgid / NXCD; wgid = (xcd < r ? xcd * (q + 1) : r * (q + 1) + (xcd - r) * q) + off; }
        const int nig = WGM * nN, gid = wgid / nig, fm = gid * WGM, gsz = (nM - fm) < WGM ? (nM - fm) : WGM;
        u.pm = fm + ((wgid % nig) % gsz); u.pn = (wgid % nig) / gsz; return true;
    }
};

__device__ __forceinline__ void gemm_big(LAS unsigned char* lds, const GemmDesc* gd, const bool do_epi = true) {
    int tid_ = threadIdx.x; asm volatile("" : "+v"(tid_));
    const int tid = tid_, wid = __builtin_amdgcn_readfirstlane(tid >> 6), lane = tid & 63, wr = wid >> 2, wc = wid & 3, fr = lane & 15, fq = lane >> 4;
    const GemmHead g = load_head(gd);
    const int ekind = g.kind;
    const int K = g.K, nt = K / BK;
    StaticOrder S; S.init(g.nM, g.nN, gridDim.x, blockIdx.x);
    unsigned voffA[2], voffB[2];
#pragma unroll
    for (int i = 0; i < 2; ++i) { int R, C; stage_rc(tid * 16 + i * 8192, R, C); voffA[i] = (unsigned)(R * g.lda + C) * 2u; voffB[i] = (unsigned)(R * g.ldb + C) * 2u; }
    const size_t kstep = (size_t)(BK * 2);
    const size_t hstepA = (size_t)HALF * g.lda * 2, hstepB = (size_t)HALF * g.ldb * 2;
    const size_t tstepA = 2 * hstepA, tstepB = 2 * hstepB;
    const unsigned ldsw = (unsigned)wid * 1024u;
    const int aoff = lds_byte(wr * 64 + fr, fq * 8), boff = lds_byte(wc * 32 + fr, fq * 8);
#define PG8_SA(b, h) (((b) * 2 + (h)) * HTB)
#define PG8_SB(b, h) ((4 + (b) * 2 + (h)) * HTB)
#define PG8_STAGE(bufoff, gbase, voff) do { _Pragma("unroll") for (int _i = 0; _i < 2; ++_i) \
        __builtin_amdgcn_global_load_lds((const unsigned*)((const char*)(gbase) + (voff)[_i]), (LAS unsigned*)(lds + (bufoff) + ldsw + _i * 8192), 16, 0, 0); } while (0)
#define PG8_LDA(dst, b, h) do { _Pragma("unroll") for (int m = 0; m < 4; ++m) _Pragma("unroll") for (int k = 0; k < 2; ++k) dst[m][k] = *(const LAS bf16x8*)(lds + PG8_SA(b, h) + aoff + m * 2048 + k * 1024); } while (0)
#define PG8_LDB(dst, b, h) do { _Pragma("unroll") for (int n = 0; n < 2; ++n) _Pragma("unroll") for (int k = 0; k < 2; ++k) dst[n][k] = *(const LAS bf16x8*)(lds + PG8_SB(b, h) + boff + n * 2048 + k * 1024); } while (0)
#define PG8_MMA(ai, bj, At, Bt) do { __builtin_amdgcn_s_setprio(1); _Pragma("unroll") for (int m = 0; m < 4; ++m) _Pragma("unroll") for (int n = 0; n < 2; ++n) _Pragma("unroll") for (int k = 0; k < 2; ++k) \
        acc[ai][bj][m][n] = __builtin_amdgcn_mfma_f32_16x16x32_bf16(Bt[n][k], At[m][k], acc[ai][bj][m][n], 0, 0, 0); __builtin_amdgcn_s_setprio(0); } while (0)
#define PG8_WAIT_V(n) asm volatile("s_waitcnt vmcnt(" #n ")" ::: "memory")
#define PG8_WAIT_L(n) asm volatile("s_waitcnt lgkmcnt(" #n ")" ::: "memory")
#define PG8_BAR __builtin_amdgcn_s_barrier()
#define PG8_SCHED __builtin_amdgcn_sched_barrier(0)
    Unit cur, nxt; int ui = 0;
    if (!S.next(0, cur)) return;
    f32x4 acc[2][2][4][2];
#pragma unroll
    for (int a = 0; a < 2; ++a)
#pragma unroll
        for (int b = 0; b < 2; ++b)
#pragma unroll
            for (int m = 0; m < 4; ++m)
#pragma unroll
                for (int n = 0; n < 2; ++n) acc[a][b][m][n] = (f32x4){0.f, 0.f, 0.f, 0.f};
    bf16x8 At[4][2], B0[2][2], B1[2][2];
    const char* cA = (const char*)g.A + (size_t)cur.pm * tstepA; const char* cB = (const char*)g.Bt + (size_t)cur.pn * tstepB;
    PG8_STAGE(PG8_SB(0, 0), cB, voffB); PG8_STAGE(PG8_SA(0, 0), cA, voffA); PG8_STAGE(PG8_SB(0, 1), cB + hstepB, voffB); PG8_STAGE(PG8_SA(0, 1), cA + hstepA, voffA);
    if (wr == 1) PG8_BAR;
    PG8_WAIT_V(4); PG8_BAR;
    PG8_STAGE(PG8_SB(1, 0), cB + kstep, voffB); PG8_STAGE(PG8_SA(1, 0), cA + kstep, voffA); PG8_STAGE(PG8_SB(1, 1), cB + hstepB + kstep, voffB);
    PG8_WAIT_V(6); PG8_BAR;
    for (;;) {
        const bool has_next = S.next(ui + 1, nxt);
        const char* nA = has_next ? (const char*)g.A + (size_t)nxt.pm * tstepA : cA; const char* nB = has_next ? (const char*)g.Bt + (size_t)nxt.pn * tstepB : cB;
        for (int t = 0; t < nt; t += 2) {
            const bool last = (t == nt - 2);
            const char* a1 = cA + (size_t)(t + 1) * kstep;
            const char* a2 = last ? nA : cA + (size_t)(t + 2) * kstep; const char* b2 = last ? nB : cB + (size_t)(t + 2) * kstep;
            const char* a3 = a2 + kstep; const char* b3 = b2 + kstep;
            PG8_LDB(B0, 0, 0); PG8_SCHED; PG8_LDA(At, 0, 0); PG8_STAGE(PG8_SA(1, 1), a1 + hstepA, voffA);
            PG8_WAIT_L(8); PG8_BAR; PG8_WAIT_L(0); PG8_MMA(0, 0, At, B0); PG8_BAR; PG8_SCHED;
            PG8_LDB(B1, 0, 1); PG8_STAGE(PG8_SB(0, 0), b2, voffB);
            PG8_BAR; PG8_WAIT_L(0); PG8_MMA(0, 1, At, B1); PG8_BAR;
            PG8_LDA(At, 0, 1); PG8_STAGE(PG8_SA(0, 0), a2, voffA);
            PG8_BAR; PG8_WAIT_L(0); PG8_MMA(1, 0, At, B0); PG8_BAR; PG8_SCHED;
            PG8_STAGE(PG8_SB(0, 1), b2 + hstepB, voffB);
            PG8_WAIT_V(6); PG8_BAR; PG8_MMA(1, 1, At, B1); PG8_BAR;
            PG8_LDB(B0, 1, 0); PG8_SCHED; PG8_LDA(At, 1, 0); PG8_STAGE(PG8_SA(0, 1), a2 + hstepA, voffA);
            PG8_WAIT_L(8); PG8_BAR; PG8_WAIT_L(0); PG8_MMA(0, 0, At, B0); PG8_BAR; PG8_SCHED;
            PG8_LDB(B1, 1, 1); PG8_STAGE(PG8_SB(1, 0), b3, voffB);
            PG8_BAR; PG8_WAIT_L(0); PG8_MMA(0, 1, At, B1); PG8_BAR;
            PG8_LDA(At, 1, 1); PG8_STAGE(PG8_SA(1, 0), a3, voffA);
            PG8_BAR; PG8_WAIT_L(0); PG8_MMA(1, 0, At, B0); PG8_BAR; PG8_SCHED;
            PG8_STAGE(PG8_SB(1, 1), b3 + hstepB, voffB);
            PG8_WAIT_V(6); PG8_BAR; PG8_MMA(1, 1, At, B1); PG8_BAR;
        }
        if (do_epi) switch (ekind) {
            case EK_FFN1: epi_big<EK_FFN1>(gd, acc, cur.pm, cur.pn, wr, wc, fr, fq); break;
            case EK_RES: epi_big<EK_RES>(gd, acc, cur.pm, cur.pn, wr, wc, fr, fq); break;
            case EK_GELU_UV: epi_big<EK_GELU_UV>(gd, acc, cur.pm, cur.pn, wr, wc, fr, fq); break;
            case EK_STORE: epi_big<EK_STORE>(gd, acc, cur.pm, cur.pn, wr, wc, fr, fq); break;
            case EK_CONVZ: epi_big<EK_CONVZ>(gd, acc, cur.pm, cur.pn, wr, wc, fr, fq); break;
            case EK_PLE: epi_big<EK_PLE>(gd, acc, cur.pm, cur.pn, wr, wc, fr, fq); break;
            case EK_BIN: epi_big<EK_BIN>(gd, acc, cur.pm, cur.pn, wr, wc, fr, fq); break;
            default: epi_big<EK_BL2>(gd, acc, cur.pm, cur.pn, wr, wc, fr, fq); break;
        }
        if (!has_next) break;
#pragma unroll
        for (int a = 0; a < 2; ++a)
#pragma unroll
            for (int b = 0; b < 2; ++b)
#pragma unroll
                for (int m = 0; m < 4; ++m)
#pragma unroll
                    for (int n = 0; n < 2; ++n) acc[a][b][m][n] = (f32x4){0.f, 0.f, 0.f, 0.f};
        cur = nxt; cA = nA; cB = nB; ++ui;
    }
    PG8_WAIT_V(0);
    if (wr == 0) PG8_BAR;
    PG8_BAR;
#undef PG8_SA
#undef PG8_SB
#undef PG8_STAGE
#undef PG8_LDA
#undef PG8_LDB
#undef PG8_MMA
#undef PG8_WAIT_V
#undef PG8_WAIT_L
#undef PG8_BAR
#undef PG8_SCHED
}

template <int KIND> __device__ __forceinline__ void small_epi(const EpiG& e, int row, int col, f32x4 v0, f32x4 v1) { epi_elem<KIND>(e, row, col, v0, v1); }
__device__ __forceinline__ void gemm_small(LAS unsigned char* lds, const GemmDesc* gd) {
    int tid_ = threadIdx.x; asm volatile("" : "+v"(tid_));
    const int tid = tid_, wid = __builtin_amdgcn_readfirstlane(tid >> 6), lane = tid & 63, fr = lane & 15, fq = lane >> 4;
    const GemmHead g = load_head(gd);
    if (g.nM != MP / BM) return;
    const int ekind = g.kind;
    const bool paired = (ekind == EK_FFN1 || ekind == EK_CONVZ);
    const int ncu = paired ? g.nN * 4 : g.nN * 4;
    const int nunits = 8 * ncu;
    const int kq = wid >> 1, nh = wid & 1;
    const int ks = g.K >> 2;
    LAS f32x4* P = (LAS f32x4*)lds;
    for (int su = (int)(gridDim.x - 1 - blockIdx.x); su < nunits; su += gridDim.x) {
        const int rp = su & 7, cu = su >> 3;
        const int row0 = MP + rp * 64;
        int brow[2];
#pragma unroll
        for (int j = 0; j < 2; ++j) { const int nb = nh * 2 + j;
            if (paired) { const int p0 = cu * 32; brow[j] = (p0 >> 7) * 256 + (nb >> 1) * 128 + (p0 & 127) + (nb & 1) * 16 + fr; }
            else brow[j] = cu * 64 + nb * 16 + fr; }
        const GAS bf16_t* ap = g.A + (size_t)(row0 + fr) * g.lda + kq * ks + fq * 8;
        const GAS bf16_t* bp0 = g.Bt + (size_t)brow[0] * g.ldb + kq * ks + fq * 8;
        const GAS bf16_t* bp1 = g.Bt + (size_t)brow[1] * g.ldb + kq * ks + fq * 8;
        f32x4 acc[4][2];
#pragma unroll
        for (int m = 0; m < 4; ++m) { acc[m][0] = (f32x4){0.f, 0.f, 0.f, 0.f}; acc[m][1] = (f32x4){0.f, 0.f, 0.f, 0.f}; }
#pragma unroll 2
        for (int k = 0; k < ks; k += 32) {
            bf16x8 a[4], b[2];
#pragma unroll
            for (int m = 0; m < 4; ++m) a[m] = *(const GAS bf16x8*)(ap + (size_t)(m * 16) * g.lda + k);
            b[0] = *(const GAS bf16x8*)(bp0 + k); b[1] = *(const GAS bf16x8*)(bp1 + k);
#pragma unroll
            for (int m = 0; m < 4; ++m) { acc[m][0] = __builtin_amdgcn_mfma_f32_16x16x32_bf16(b[0], a[m], acc[m][0], 0, 0, 0); acc[m][1] = __builtin_amdgcn_mfma_f32_16x16x32_bf16(b[1], a[m], acc[m][1], 0, 0, 0); }
        }
#pragma unroll
        for (int m = 0; m < 4; ++m)
#pragma unroll
            for (int j = 0; j < 2; ++j) P[((kq * 4 + m) * 4 + nh * 2 + j) * 64 + lane] = acc[m][j];
        __syncthreads();
        {   const int m = wid >> 1, s = wid & 1;
            f32x4 v0 = (f32x4){0.f, 0.f, 0.f, 0.f}, v1 = v0;
#pragma unroll
            for (int q = 0; q < 4; ++q) { v0 += P[((q * 4 + m) * 4 + s) * 64 + lane]; v1 += P[((q * 4 + m) * 4 + s + 2) * 64 + lane]; }
            const int row = row0 + m * 16 + fr;
            const int cA_ = paired ? cu * 32 + s * 16 + fq * 4 : cu * 64 + s * 16 + fq * 4;
            const int cB_ = cu * 64 + (s + 2) * 16 + fq * 4;
            const EpiG e = load_epi(gd);
            switch (ekind) {
                case EK_FFN1: small_epi<EK_FFN1>(e, row, cA_, v0, v1); break;
                case EK_CONVZ: small_epi<EK_CONVZ>(e, row, cA_, v0, v1); break;
                case EK_RES: small_epi<EK_RES>(e, row, cA_, v0, v0); small_epi<EK_RES>(e, row, cB_, v1, v1); break;
                case EK_GELU_UV: small_epi<EK_GELU_UV>(e, row, cA_, v0, v0); small_epi<EK_GELU_UV>(e, row, cB_, v1, v1); break;
                case EK_STORE: small_epi<EK_STORE>(e, row, cA_, v0, v0); small_epi<EK_STORE>(e, row, cB_, v1, v1); break;
                case EK_PLE: small_epi<EK_PLE>(e, row, cA_, v0, v0); small_epi<EK_PLE>(e, row, cB_, v1, v1); break;
                case EK_BIN: small_epi<EK_BIN>(e, row, cA_, v0, v0); small_epi<EK_BIN>(e, row, cB_, v1, v1); break;
                default: small_epi<EK_BL2>(e, row, cA_, v0, v0); small_epi<EK_BL2>(e, row, cB_, v1, v1); break;
            }
        }
        __syncthreads();
    }
}

__device__ __forceinline__ int srccol(int mode, int n0) {
    if (mode == 1) { const int pn = n0 >> 8, bj = (n0 >> 7) & 1, l = n0 & 127; return bj * DFF + pn * 128 + l; }
    if (mode == 2) { if (n0 < 2048) { const int pn = n0 >> 8, bj = (n0 >> 7) & 1, l = n0 & 127; return 1024 * (1 + bj) + pn * 128 + l; } return n0 - 2048; }
    return n0;
}
__device__ __forceinline__ void tconv(LAS float* tile, int& base, const float* src, int ld, int K, int ncols, bf16_t* dst, int ldd, int koff, int mode, const float* scale) {
    int tid_ = threadIdx.x; asm volatile("" : "+v"(tid_));
    const int nkt = K >> 6, ntl = nkt * (ncols >> 6), G = gridDim.x, tid = tid_;
    int t0 = ((int)blockIdx.x - (base % G) + G) % G; base += ntl;
    for (int t = t0; t < ntl; t += G) {
        const int kt = t % nkt, n0 = (t / nkt) * 64, k0 = kt * 64, sc0 = srccol(mode, n0);
        __syncthreads();
#pragma unroll
        for (int i = 0; i < 2; ++i) { const int kk = (tid >> 4) + i * 32, n4 = (tid & 15) * 4;
            f32x4 v = *(const f32x4*)(src + (size_t)(k0 + kk) * ld + sc0 + n4);
            if (scale) v = v * scale[k0 + kk];
#pragma unroll
            for (int j = 0; j < 4; ++j) tile[kk * 65 + n4 + j] = v[j]; }
        __syncthreads();
        { const int nn = tid >> 3, k8 = (tid & 7) * 8; u32x4 w;
            w.x = cvt_pk_bf16(tile[(k8 + 0) * 65 + nn], tile[(k8 + 1) * 65 + nn]); w.y = cvt_pk_bf16(tile[(k8 + 2) * 65 + nn], tile[(k8 + 3) * 65 + nn]);
            w.z = cvt_pk_bf16(tile[(k8 + 4) * 65 + nn], tile[(k8 + 5) * 65 + nn]); w.w = cvt_pk_bf16(tile[(k8 + 6) * 65 + nn], tile[(k8 + 7) * 65 + nn]);
            *(u32x4*)(dst + (size_t)(n0 + nn) * ldd + koff + k0 + k8) = w; }
    }
}
__device__ __forceinline__ void prep_phase(const Params& p, LAS unsigned char* lds) {
    const Ctx cx = mkctx(p);
    LAS float* tile = (LAS float*)lds; unsigned char* ws = cx.ws; int base = 0;
    const size_t gt = (size_t)blockIdx.x * 512 + cx.tid, gn = (size_t)gridDim.x * 512;
    for (int q = 0; q < 8; ++q) tconv(tile, base, p.in[9] + (size_t)q * 1024 * 5632, 5632, 1024, 5632, (bf16_t*)(ws + W_FFN_IN) + (size_t)q * 5632 * 1024, 1024, 0, 1, nullptr);
    for (int q = 0; q < 8; ++q) tconv(tile, base, p.in[10] + (size_t)q * 2816 * 1024, 1024, 2816, 1024, (bf16_t*)(ws + W_FFN_OUT) + (size_t)q * 1024 * 2816, 2816, 0, 0, nullptr);
    for (int i = 0; i < 4; ++i) tconv(tile, base, p.in[11] + (size_t)i * 1024 * 1024, 1024, 1024, 1024, (bf16_t*)(ws + W_PLE_G) + (size_t)i * 1024 * 1024, 1024, 0, 0, nullptr);
    for (int i = 0; i < 4; ++i) tconv(tile, base, p.in[12] + (size_t)i * 256 * 1024, 1024, 256, 1024, (bf16_t*)(ws + W_PLE_P) + (size_t)i * 1024 * 256, 256, 0, 0, nullptr);
    for (int j = 0; j < 2; ++j) tconv(tile, base, p.in[13] + (size_t)j * 1024 * 4096, 4096, 1024, 4096, (bf16_t*)(ws + W_A_IN) + (size_t)j * 4096 * 1024, 1024, 0, 0, nullptr);
    for (int j = 0; j < 2; ++j) tconv(tile, base, p.in[19] + (size_t)j * 2048 * 1024, 1024, 2048, 1024, (bf16_t*)(ws + W_A_OUT) + (size_t)j * 1024 * 2048, 2048, 0, 0, nullptr);
    bf16_t* bin = (bf16_t*)(ws + W_B_IN);
    for (int q = 0; q < 3; ++q) { const int mi = q == 0 ? 0 : (q == 1 ? 2 : 3);
        tconv(tile, base, p.in[21] + (size_t)q * 1024 * 1024, 1024, 1024, 1024, bin + (size_t)q * 1024 * 2048, 2048, 0, 0, nullptr);
        tconv(tile, base, p.in[21] + (size_t)q * 1024 * 1024, 1024, 1024, 1024, bin + (size_t)q * 1024 * 2048, 2048, 1024, 0, p.in[20] + mi * 1024); }
    tconv(tile, base, p.in[23], 64, 1024, 64, bin + (size_t)3072 * 2048, 2048, 0, 0, nullptr);
    tconv(tile, base, p.in[23], 64, 1024, 64, bin + (size_t)3072 * 2048, 2048, 1024, 0, p.in[20] + 1 * 1024);
    tconv(tile, base, p.in[26], 64, 1024, 64, bin + (size_t)3136 * 2048, 2048, 0, 0, nullptr);
    tconv(tile, base, p.in[26], 64, 1024, 64, bin + (size_t)3136 * 2048, 2048, 1024, 0, p.in[20] + 4 * 1024);
    tconv(tile, base, p.in[28], 128, 1024, 128, bin + (size_t)3200 * 2048, 2048, 0, 0, nullptr);
    tconv(tile, base, p.in[28], 128, 1024, 128, bin + (size_t)3200 * 2048, 2048, 1024, 0, p.in[20] + 5 * 1024);
    tconv(tile, base, p.in[35], 1024, 1024, 1024, (bf16_t*)(ws + W_B_O), 1024, 0, 0, nullptr);
    tconv(tile, base, p.in[36], 3072, 1024, 3072, (bf16_t*)(ws + W_C_IN), 1024, 0, 2, nullptr);
    tconv(tile, base, p.in[38], 1024, 1024, 1024, (bf16_t*)(ws + W_C_OUT), 1024, 0, 0, nullptr);
    { bf16_t* l2 = (bf16_t*)(ws + W_B_L2);
        for (size_t i = gt; i < (size_t)3072 * 256; i += gn) { const int n = (int)(i >> 8), k = (int)(i & 255); float v = 0.f;
            if (n < 1024) { if (k < 64) v = p.in[24][k * 1024 + n]; }
            else if (n < 2048) { if (k >= 64 && k < 128) v = p.in[27][(k - 64) * 1024 + (n - 1024)]; }
            else { if (k >= 128) v = p.in[29][(k - 128) * 1024 + (n - 2048)]; }
            l2[i] = (bf16_t)(cvt_pk_bf16(v, 0.f) & 0xffffu); } }
    { bf16_t* as = (bf16_t*)(ws + W_A_S);
        for (size_t i = gt; i < (size_t)2 * 8 * 128 * 128; i += gn) { const int s = (int)(i & 127), t = (int)((i >> 7) & 127); const float v = s <= t ? p.in[17][i] : 0.f; as[i] = (bf16_t)(cvt_pk_bf16(v, 0.f) & 0xffffu); } }
    { float* X = cx.out + O_Y; bf16_t* xb = (bf16_t*)(ws + A_XBALT);
        for (size_t i = gt; i < (size_t)MT * 256; i += gn) { const size_t e = i * 4; const f32x4 v = e < (size_t)MP * 1024 ? *(const f32x4*)(p.in[0] + e) : *(const f32x4*)(p.in[1] + (e - (size_t)MP * 1024));
            *(f32x4*)(X + e) = v; *(u32x2*)(xb + e) = f4_to_bf4(v); } }
}

__device__ __forceinline__ void ln_phase(const Params& p, int layer, int which, bool write_pb) {
    const Ctx cx = mkctx(p);
    const int lane = cx.tid & 63, gw = blockIdx.x * 8 + (cx.tid >> 6), nw = gridDim.x * 8;
    float* X = cx.out + O_Y; bf16_t* xb = (bf16_t*)(cx.ws + A_XB);
    const float* g = p.in[7] + (size_t)(layer * 3 + which) * 1024; const float* b = p.in[8] + (size_t)(layer * 3 + which) * 1024;
    f32x4 gv[4], bv[4];
#pragma unroll
    for (int i = 0; i < 4; ++i) { gv[i] = *(const f32x4*)(g + i * 256 + lane * 4); bv[i] = *(const f32x4*)(b + i * 256 + lane * 4); }
    for (int rq = gw; rq < MT / 4; rq += nw) {
        f32x4 v[4][4]; float sm[4];
#pragma unroll
        for (int r = 0; r < 4; ++r) { sm[r] = 0.f;
#pragma unroll
            for (int i = 0; i < 4; ++i) { v[r][i] = *(const f32x4*)(X + (size_t)(rq * 4 + r) * 1024 + i * 256 + lane * 4); sm[r] += (v[r][i][0] + v[r][i][1]) + (v[r][i][2] + v[r][i][3]); } }
#pragma unroll
        for (int o = 32; o >= 1; o >>= 1) {
#pragma unroll
            for (int r = 0; r < 4; ++r) sm[r] += __shfl_xor(sm[r], o); }
        float qq[4];
#pragma unroll
        for (int r = 0; r < 4; ++r) { const float mean = sm[r] * (1.0f / 1024.0f); qq[r] = 0.f;
#pragma unroll
            for (int i = 0; i < 4; ++i) { v[r][i] = v[r][i] - mean; qq[r] += (v[r][i][0] * v[r][i][0] + v[r][i][1] * v[r][i][1]) + (v[r][i][2] * v[r][i][2] + v[r][i][3] * v[r][i][3]); } }
#pragma unroll
        for (int o = 32; o >= 1; o >>= 1) {
#pragma unroll
            for (int r = 0; r < 4; ++r) qq[r] += __shfl_xor(qq[r], o); }
#pragma unroll
        for (int r = 0; r < 4; ++r) { const float rstd = rsqrtf(qq[r] * (1.0f / 1024.0f) + 1e-5f); const size_t ro = (size_t)(rq * 4 + r) * 1024;
#pragma unroll
            for (int i = 0; i < 4; ++i) { const f32x4 y = v[r][i] * rstd * gv[i] + bv[i]; *(f32x4*)(X + ro + i * 256 + lane * 4) = y; *(u32x2*)(xb + ro + i * 256 + lane * 4) = f4_to_bf4(y); } }
    }
    if (write_pb) { bf16_t* pb = (bf16_t*)(cx.ws + A_PB); const size_t gt = (size_t)blockIdx.x * 512 + cx.tid, gn = (size_t)gridDim.x * 512;
        for (size_t i = gt; i < (size_t)MT * 64; i += gn) { const size_t e = i * 4; const f32x4 v = e < (size_t)MP * 256 ? *(const f32x4*)(p.in[5] + (size_t)layer * MP * 256 + e) : *(const f32x4*)(p.in[6] + (size_t)layer * MS * 256 + (e - (size_t)MP * 256));
            *(u32x2*)(pb + e) = f4_to_bf4(v); } }
}
__device__ __forceinline__ void shift_phase(const Params& p0) {
    const Ctx cx = mkctx(p0); Params p = p0; p.ws = cx.ws; p.out = cx.out;
    const int lane = cx.tid & 63, gw = blockIdx.x * 8 + (cx.tid >> 6), nw = gridDim.x * 8;
    const float* X = p.out + O_Y; bf16_t* xc = (bf16_t*)(p.ws + A_XCAT);
    for (int row = gw; row < MT; row += nw) {
        int b, t, T; const float* prevp; float* shout;
        if (row < MP) { b = row >> 11; t = row & 2047; T = 2048; prevp = nullptr; shout = p.out + O_SHP + (size_t)b * 1024; }
        else { const int r = row - MP; b = r >> 2; t = r & 3; T = 4; prevp = p.in[3] + (size_t)b * 1024; shout = p.out + O_SHS + (size_t)b * 1024; }
        if (t > 0) prevp = X + (size_t)(row - 1) * 1024;
#pragma unroll
        for (int i = 0; i < 4; ++i) { const int c = i * 256 + lane * 4; const f32x4 x = *(const f32x4*)(X + (size_t)row * 1024 + c);
            const f32x4 pv = prevp ? *(const f32x4*)(prevp + c) : (f32x4){0.f, 0.f, 0.f, 0.f};
            *(u32x2*)(xc + (size_t)row * 2048 + c) = f4_to_bf4(x); *(u32x2*)(xc + (size_t)row * 2048 + 1024 + c) = f4_to_bf4(pv - x);
            if (t == T - 1) *(f32x4*)(shout + c) = x; }
    }
}
__device__ __forceinline__ void lnv_phase(const Params& p0, int jA) {
    const Ctx cx = mkctx(p0); Params p = p0; p.ws = cx.ws; p.out = cx.out;
    const int lane = cx.tid & 63, gw = blockIdx.x * 8 + (cx.tid >> 6), nw = gridDim.x * 8;
    const float* V = (const float*)(p.ws + A_V); bf16_t* vn = (bf16_t*)(p.ws + A_VN);
    const float* g = p.in[15] + (size_t)jA * 2048; const float* b = p.in[16] + (size_t)jA * 2048;
    for (int row = gw; row < MP; row += nw) {
        f32x4 v[8]; float s = 0.f;
#pragma unroll
        for (int i = 0; i < 8; ++i) { v[i] = *(const f32x4*)(V + (size_t)row * 2048 + i * 256 + lane * 4); s += (v[i][0] + v[i][1]) + (v[i][2] + v[i][3]); }
        const float mean = wave_sum(s) * (1.0f / 2048.0f); float q = 0.f;
#pragma unroll
        for (int i = 0; i < 8; ++i) { v[i] = v[i] - mean; q += (v[i][0] * v[i][0] + v[i][1] * v[i][1]) + (v[i][2] * v[i][2] + v[i][3] * v[i][3]); }
        const float rstd = rsqrtf(wave_sum(q) * (1.0f / 2048.0f) + 1e-5f);
#pragma unroll
        for (int i = 0; i < 8; ++i) { const int c = i * 256 + lane * 4; const f32x4 y = v[i] * rstd * *(const f32x4*)(g + c) + *(const f32x4*)(b + c); *(u32x2*)(vn + (size_t)row * 2048 + c) = f4_to_bf4(y); }
    }
    const bf16_t* U = (const bf16_t*)(p.ws + A_U); bf16_t* yb = (bf16_t*)(p.ws + A_YB);
    const float* wsp = p.in[17] + (size_t)jA * 8 * 128 * 128; const float* bsp = p.in[18] + (size_t)jA * 8 * 128;
    for (int bb = nw - 1 - gw; bb < 128; bb += nw) {
        float mean[4], rstd[4];
#pragma unroll
        for (int t = 0; t < 4; ++t) { const int row = MP + bb * 4 + t; f32x4 v[8]; float s = 0.f;
#pragma unroll
            for (int i = 0; i < 8; ++i) { v[i] = *(const f32x4*)(V + (size_t)row * 2048 + i * 256 + lane * 4); s += (v[i][0] + v[i][1]) + (v[i][2] + v[i][3]); }
            mean[t] = wave_sum(s) * (1.0f / 2048.0f); float q = 0.f;
#pragma unroll
            for (int i = 0; i < 8; ++i) { v[i] = v[i] - mean[t]; q += (v[i][0] * v[i][0] + v[i][1] * v[i][1]) + (v[i][2] * v[i][2] + v[i][3] * v[i][3]); }
            rstd[t] = rsqrtf(wave_sum(q) * (1.0f / 2048.0f) + 1e-5f); }
        for (int i = 0; i < 8; ++i) { const int c = i * 256 + lane * 4, h = i;
            const f32x4 g4 = *(const f32x4*)(g + c), b4 = *(const f32x4*)(b + c); f32x4 n[4];
#pragma unroll
            for (int t = 0; t < 4; ++t) { const int row = MP + bb * 4 + t; n[t] = (*(const f32x4*)(V + (size_t)row * 2048 + c) - mean[t]) * rstd[t] * g4 + b4;
                *(f32x4*)(p.out + O_AV + ((size_t)jA * 512 + bb * 4 + t) * 2048 + c) = n[t]; }
#pragma unroll
            for (int t = 0; t < 4; ++t) { const int row = MP + bb * 4 + t; const float bs = bsp[h * 128 + t]; f32x4 mx = (f32x4){bs, bs, bs, bs};
#pragma unroll
                for (int s = 0; s <= t; ++s) mx += n[s] * wsp[(h * 128 + t) * 128 + s];
                const f32x4 u = bf4_to_f4(*(const u32x2*)(U + (size_t)row * 2048 + c)); *(u32x2*)(yb + (size_t)row * 2048 + c) = f4_to_bf4(u * mx); }
        }
    }
}
__device__ __forceinline__ void spatial_phase(const Params& p0, int jA, LAS unsigned char* lds) {
    const Ctx cx = mkctx(p0); Params p = p0; p.ws = cx.ws; p.out = cx.out;
    const int tid = cx.tid, wid = tid >> 6, lane = tid & 63, fr = lane & 15, fq = lane >> 4;
    const bf16_t* vn = (const bf16_t*)(p.ws + A_VN); const bf16_t* U = (const bf16_t*)(p.ws + A_U); bf16_t* yb = (bf16_t*)(p.ws + A_YB);
    const bf16_t* was = (const bf16_t*)(p.ws + W_A_S) + (size_t)jA * 8 * 128 * 128; const float* bsp = p.in[18] + (size_t)jA * 8 * 128;
    constexpr int RS = 516;
    for (int u = blockIdx.x; u < 1024; u += gridDim.x) {
        const int c = u >> 3, h = u & 7;
        __syncthreads();
        for (int i = tid; i < 128 * 32; i += 512) { const int s = i >> 5, c8 = (i & 31) * 8; const u32x4 w = *(const u32x4*)(vn + (size_t)(c * 128 + s) * 2048 + h * 256 + c8);
            LAS unsigned* d = (LAS unsigned*)(lds + s * RS + c8 * 2); d[0] = w.x; d[1] = w.y; d[2] = w.z; d[3] = w.w; }
        __syncthreads();
        bf16x8 vf[2][4];
#pragma unroll
        for (int n = 0; n < 2; ++n)
#pragma unroll
            for (int kb = 0; kb < 4; ++kb)
#pragma unroll
                for (int j = 0; j < 8; ++j) vf[n][kb][j] = (short)*(const LAS unsigned short*)(lds + (kb * 32 + fq * 8 + j) * RS + (wid * 32 + n * 16 + fr) * 2);
        for (int tb = 0; tb < 8; ++tb) {
            f32x4 acc[2]; acc[0] = (f32x4){0.f, 0.f, 0.f, 0.f}; acc[1] = acc[0];
            const bf16_t* wrow = was + (size_t)(h * 128 + tb * 16 + fr) * 128 + fq * 8;
#pragma unroll
            for (int kb = 0; kb < 4; ++kb) if (kb <= (tb >> 1)) { const bf16x8 wf = *(const bf16x8*)(wrow + kb * 32);
                acc[0] = __builtin_amdgcn_mfma_f32_16x16x32_bf16(vf[0][kb], wf, acc[0], 0, 0, 0); acc[1] = __builtin_amdgcn_mfma_f32_16x16x32_bf16(vf[1][kb], wf, acc[1], 0, 0, 0); }
            const int row = c * 128 + tb * 16 + fr; const float bs = bsp[h * 128 + tb * 16 + fr];
#pragma unroll
            for (int n = 0; n < 2; ++n) { const int col = h * 256 + wid * 32 + n * 16 + fq * 4; const f32x4 uu = bf4_to_f4(*(const u32x2*)(U + (size_t)row * 2048 + col));
                *(u32x2*)(yb + (size_t)row * 2048 + col) = f4_to_bf4(uu * (acc[n] + bs)); }
        }
    }
}
__device__ __forceinline__ void conv_phase(const Params& p0) {
    const Ctx cx = mkctx(p0); Params p = p0; p.ws = cx.ws; p.out = cx.out;
    const float* Z = (const float*)(p.ws + A_Z); const float* BG = (const float*)(p.ws + A_BG); bf16_t* yc = (bf16_t*)(p.ws + A_YC);
    const float* cw = p.in[37];
    const size_t gt = (size_t)blockIdx.x * 512 + cx.tid, gn = (size_t)gridDim.x * 512;
    for (size_t i = gt; i < (size_t)MT * 256; i += gn) {
        const int row = (int)(i >> 8), c = (int)(i & 255) * 4; int b, t, T; const float* buf; float* cvout;
        if (row < MP) { b = row >> 11; t = row & 2047; T = 2048; buf = nullptr; cvout = p.out + O_CVP + (size_t)b * 2048; }
        else { const int r = row - MP; b = r >> 2; t = r & 3; T = 4; buf = p.in[4] + (size_t)b * 2048; cvout = p.out + O_CVS + (size_t)b * 2048; }
        const f32x4 z0 = *(const f32x4*)(Z + (size_t)row * 1024 + c); const f32x4 zero = (f32x4){0.f, 0.f, 0.f, 0.f};
        const f32x4 z1 = t >= 1 ? *(const f32x4*)(Z + (size_t)(row - 1) * 1024 + c) : (buf ? *(const f32x4*)(buf + 1024 + c) : zero);
        const f32x4 z2 = t >= 2 ? *(const f32x4*)(Z + (size_t)(row - 2) * 1024 + c) : (buf ? *(const f32x4*)(buf + (size_t)t * 1024 + c) : zero);
        const f32x4 cv = *(const f32x4*)(cw + c) * z2 + *(const f32x4*)(cw + 1024 + c) * z1 + *(const f32x4*)(cw + 2048 + c) * z0;
        const f32x4 bg = *(const f32x4*)(BG + (size_t)row * 1024 + c);
        *(u32x2*)(yc + (size_t)row * 1024 + c) = f4_to_bf4(bg * cv);
        if (t >= T - 2) *(f32x4*)(cvout + (size_t)(t - (T - 2)) * 1024 + c) = z0;
    }
}
__device__ __forceinline__ void scan_unit(const Params& p0, LAS unsigned char* lds, int rowbase, int T, int h, const float* s0, float* sout) {
    constexpr int TC = 32, BUF = 6 * TC * 64 * 4 + 256;
    const Ctx cx = mkctx(p0); Params p = p0; p.ws = cx.ws; p.out = cx.out;
    const int tid = cx.tid, wid = tid >> 6, lane = tid & 63, ksg = lane & 15, rl = lane >> 4;
    const int row0 = wid * 8 + rl * 2;
    const float* R = (const float*)(p.ws + A_R); const float* Kp = R + (size_t)MT * 1024; const float* Vp = Kp + (size_t)MT * 1024; const float* DEC = (const float*)(p.ws + A_DEC);
    const bf16_t* AA = (const bf16_t*)(p.ws + A_AA); const bf16_t* GG = (const bf16_t*)(p.ws + A_GG); bf16_t* outp = (bf16_t*)(p.ws + A_OUTPRE);
    LAS float* Y = (LAS float*)(lds + 2 * BUF);
    const int st = tid >> 4, se = (tid & 15) * 4, hc = h * 64 + se;
    const f32x4 kk_w = *(const f32x4*)(p.in[30] + hc), ka_w = *(const f32x4*)(p.in[31] + hc), rk_w = *(const f32x4*)(p.in[32] + hc);
    const f32x4 lg = *(const f32x4*)(p.in[33] + hc), lb = *(const f32x4*)(p.in[34] + hc);
    f32x4 S0, S1;
    if (s0) { S0 = *(const f32x4*)(s0 + (size_t)row0 * 64 + ksg * 4); S1 = *(const f32x4*)(s0 + (size_t)(row0 + 1) * 64 + ksg * 4); }
    else { S0 = (f32x4){0.f, 0.f, 0.f, 0.f}; S1 = S0; }
    f32x4 gr, gk, gv, gd; u32x2 ga;
    const f32x4 zero = (f32x4){0.f, 0.f, 0.f, 0.f};
#define SCAN_LOAD(t0) do { const bool ok_ = (t0) + st < T; const size_t o_ = (size_t)(rowbase + (t0) + st) * 1024 + hc; \
        gr = ok_ ? *(const f32x4*)(R + o_) : zero; gk = ok_ ? *(const f32x4*)(Kp + o_) : zero; gv = ok_ ? *(const f32x4*)(Vp + o_) : zero; gd = ok_ ? *(const f32x4*)(DEC + o_) : zero; \
        ga = ok_ ? *(const u32x2*)(AA + o_) : (u32x2){0u, 0u}; } while (0)
#define SCAN_STORE(bufi) do { LAS float* B_ = (LAS float*)(lds + (bufi) * BUF); const f32x4 a_ = bf4_to_f4(ga); f32x4 kkv = gk * kk_w; \
        float ss_ = (kkv[0] * kkv[0] + kkv[1] * kkv[1]) + (kkv[2] * kkv[2] + kkv[3] * kkv[3]); ss_ = red16(ss_); \
        const float inv_ = 1.0f / fmaxf(sqrtf(ss_), 1e-12f); kkv = kkv * inv_; \
        const f32x4 km_ = gk * ((a_ - 1.0f) * ka_w + 1.0f); const f32x4 rb_ = gr * km_ * rk_w; float bs_ = (rb_[0] + rb_[1]) + (rb_[2] + rb_[3]); bs_ = red16(bs_); \
        const int o_ = st * 64 + se; *(LAS f32x4*)(B_ + o_) = gd; *(LAS f32x4*)(B_ + 2048 + o_) = kkv; *(LAS f32x4*)(B_ + 4096 + o_) = kkv * a_; \
        *(LAS f32x4*)(B_ + 6144 + o_) = km_; *(LAS f32x4*)(B_ + 8192 + o_) = gr; *(LAS f32x4*)(B_ + 10240 + o_) = gv; if ((tid & 15) == 0) B_[12288 + st] = bs_; } while (0)
    __syncthreads();
    SCAN_LOAD(0); SCAN_STORE(0);
    __syncthreads();
    const int nch = (T + TC - 1) / TC;
    for (int c = 0; c < nch; ++c) {
        const int t0 = c * TC; const int nst = (T - t0) < TC ? (T - t0) : TC;
        if (c + 1 < nch) SCAN_LOAD(t0 + TC);
        const LAS float* B = (const LAS float*)(lds + (c & 1) * BUF);
        for (int tt = 0; tt < nst; ++tt) {
            const f32x4 w = *(const LAS f32x4*)(B + tt * 64 + ksg * 4), kk = *(const LAS f32x4*)(B + 2048 + tt * 64 + ksg * 4), ka = *(const LAS f32x4*)(B + 4096 + tt * 64 + ksg * 4);
            const f32x4 km = *(const LAS f32x4*)(B + 6144 + tt * 64 + ksg * 4), rr = *(const LAS f32x4*)(B + 8192 + tt * 64 + ksg * 4);
            const f32x2 vv = *(const LAS f32x2*)(B + 10240 + tt * 64 + row0);
            float p0 = (S0[0] * kk[0] + S0[1] * kk[1]) + (S0[2] * kk[2] + S0[3] * kk[3]);
            float p1 = (S1[0] * kk[0] + S1[1] * kk[1]) + (S1[2] * kk[2] + S1[3] * kk[3]);
            p0 = red16(p0); p1 = red16(p1);
            S0 = S0 * w - ka * p0 + km * vv.x;
            S1 = S1 * w - ka * p1 + km * vv.y;
            float q0 = (S0[0] * rr[0] + S0[1] * rr[1]) + (S0[2] * rr[2] + S0[3] * rr[3]);
            float q1 = (S1[0] * rr[0] + S1[1] * rr[1]) + (S1[2] * rr[2] + S1[3] * rr[3]);
            q0 = red16(q0); q1 = red16(q1);
            if (ksg == 0) *(LAS f32x2*)(Y + tt * 64 + row0) = (f32x2){q0, q1};
        }
        __syncthreads();
        if (st < nst) {
            const f32x4 y = *(const LAS f32x4*)(Y + st * 64 + se); const f32x4 v4 = *(const LAS f32x4*)(B + 10240 + st * 64 + se); const float bs = B[12288 + st];
            float s = (y[0] + y[1]) + (y[2] + y[3]); s = red16(s); const float mean = s * (1.0f / 64.0f);
            const f32x4 d = y - mean; float q = (d[0] * d[0] + d[1] * d[1]) + (d[2] * d[2] + d[3] * d[3]); q = red16(q);
            const float rstd = rsqrtf(q * (1.0f / 64.0f) + 64e-5f);
            const size_t o = (size_t)(rowbase + t0 + st) * 1024 + hc;
            const f32x4 g4 = bf4_to_f4(*(const u32x2*)(GG + o));
            *(u32x2*)(outp + o) = f4_to_bf4((d * rstd * lg + lb + v4 * bs) * g4);
        } else { float s = 0.f; s = red16(s); s = red16(s); (void)s; }
        if (c + 1 < nch) SCAN_STORE((c + 1) & 1);
        __syncthreads();
    }
    *(f32x4*)(sout + (size_t)row0 * 64 + ksg * 4) = S0; *(f32x4*)(sout + (size_t)(row0 + 1) * 64 + ksg * 4) = S1;
#undef SCAN_LOAD
#undef SCAN_STORE
}
__device__ __forceinline__ void scan_phase(const Params& p, LAS unsigned char* lds) {
    const int G = gridDim.x, c = blockIdx.x;
    if (c < 128 || G <= 128) {
        for (int u = c; u < 128; u += G) { const int b = u >> 4, h = u & 15; scan_unit(p, lds, b * 2048, 2048, h, nullptr, p.out + O_WKVP + (size_t)u * 4096); }
    }
    const int ns = G > 128 ? G - 128 : G, cs = G > 128 ? c - 128 : c;
    if (cs >= 0) for (int u = cs; u < 2048; u += ns) { const int b = u >> 4, h = u & 15; scan_unit(p, lds, MP + b * 4, 4, h, p.in[2] + (size_t)u * 4096, p.out + O_WKVS + (size_t)u * 4096); }
}

#define XB_TMO      128
#define XB_XCNT(j)  (256  + 64 * (j))
#define XB_XSUB(j)  (1280 + 64 * (j))
#define XB_XGEN(j)  (2304 + 64 * (j))
#define XB_TOP      3328
#define XB_TOPGEN   3392
#define XCD_BAR_WORDS 3456
#define XB_SPIN_CAP (1u << 18)

__device__ __forceinline__ unsigned xb_ld(unsigned* p)              { return __hip_atomic_load(p, __ATOMIC_RELAXED, __HIP_MEMORY_SCOPE_AGENT); }
__device__ __forceinline__ unsigned xb_add(unsigned* p, unsigned v) { return __hip_atomic_fetch_add(p, v, __ATOMIC_RELAXED, __HIP_MEMORY_SCOPE_AGENT); }
__device__ __forceinline__ unsigned xb_xcc_id() { return (unsigned)__builtin_amdgcn_s_getreg((3 << 11) | 20) & 0xFu; }
#define XB_SPIN(cond, bar) do { unsigned _sp = 0; while (cond) { __builtin_amdgcn_s_sleep(1); \
    if ((++_sp & 255u) == 0u) { if (xb_ld(&(bar)[XB_TMO])) break; if (_sp > XB_SPIN_CAP) { atomicAdd(&(bar)[XB_TMO], 1u); break; } } } } while (0)

struct XcdBarrier {
    unsigned* bar; unsigned x;
    volatile LAS unsigned* st;
};

__device__ __forceinline__ XcdBarrier xcd_barrier_post(unsigned* bar, volatile LAS unsigned* st) {
    XcdBarrier b; b.bar = bar; b.x = xb_xcc_id(); b.st = st;
    if (threadIdx.x == 0) (void)xb_add(&bar[XB_XCNT(b.x)], 1u);
    return b;
}
__device__ __forceinline__ void xcd_barrier_complete(unsigned* bar, unsigned x, unsigned& nloc, unsigned& nx) {
    const unsigned G = gridDim.x * gridDim.y * gridDim.z;
    unsigned sum, cnt, mine, sp = 0u;
    for (;;) {
        sum = 0u; cnt = 0u; mine = 0u;
#pragma unroll
        for (unsigned j = 0; j < 16; ++j) { const unsigned c = xb_ld(&bar[XB_XCNT(j)]); sum += c; cnt += (c > 0u) ? 1u : 0u; mine = (j == x) ? c : mine; }
        if (sum == G) break;
        __builtin_amdgcn_s_sleep(1);
        if ((++sp & 255u) == 0u) { if (xb_ld(&bar[XB_TMO])) break; if (sp > XB_SPIN_CAP) { atomicAdd(&bar[XB_TMO], 1u); break; } }
    }
    nloc = mine > 0u ? mine : 1u; nx = cnt > 0u ? cnt : 1u;
}

__device__ __forceinline__ void xcd_barrier(const XcdBarrier& b) {
    asm volatile("s_waitcnt vmcnt(0)" ::: "memory");
    __syncthreads();
    if (threadIdx.x == 0) {
        unsigned* bar = b.bar;
        __builtin_amdgcn_s_waitcnt(0);
        unsigned nloc = b.st[0], nx = b.st[1];
        if (nloc == 0u) { xcd_barrier_complete(bar, b.x, nloc, nx); b.st[0] = nloc; b.st[1] = nx; }
        const unsigned old = xb_add(&bar[XB_XSUB(b.x)], 1u);
        const unsigned gen = old / nloc;
        if (old + 1u == (gen + 1u) * nloc) {
            __builtin_amdgcn_fence(__ATOMIC_RELEASE, "agent");
            asm volatile("s_waitcnt vmcnt(0)" ::: "memory");
            const unsigned og = xb_add(&bar[XB_TOP], 1u);
            const unsigned tg = og / nx;
            if (og + 1u == (tg + 1u) * nx) xb_add(&bar[XB_TOPGEN], 1u);
            else XB_SPIN(xb_ld(&bar[XB_TOPGEN]) == tg, bar);
            __builtin_amdgcn_fence(__ATOMIC_ACQUIRE, "agent");
            xb_add(&bar[XB_XGEN(b.x)], 1u);
            asm volatile("s_waitcnt vmcnt(0)" ::: "memory");
        } else {
            XB_SPIN(xb_ld(&bar[XB_XGEN(b.x)]) == gen, bar);
            __builtin_amdgcn_fence(__ATOMIC_ACQUIRE, "agent");
            asm volatile("s_waitcnt vmcnt(0)" ::: "memory");
        }
    }
    __syncthreads();
}


enum { PT_PREP = 0, PT_GEMM, PT_LN, PT_SHIFT, PT_LNV, PT_SPATIAL, PT_CONV, PT_SCAN };
struct Phase { int type; int ng; int a0, a1, a2; GemmDesc g[2]; };

__device__ __forceinline__ GemmDesc mk(const void* A, int lda, const void* Bt, int ldb, int K, int N, int kind, float* f0, void* h0, void* h1, const float* c0, const float* c1, float scale, int ld, int nM = MP / BM) {
    GemmDesc g; g.A = (const bf16_t*)A; g.Bt = (const bf16_t*)Bt; g.lda = lda; g.ldb = ldb; g.K = K; g.nN = N / 256;
    g.kind = kind; g.nM = nM; g.f0 = f0; g.h0 = (bf16_t*)h0; g.h1 = (bf16_t*)h1; g.c0 = c0; g.c1 = c1; g.scale = scale; g.ld = ld; g.pad = 0; return g; }

__device__ __forceinline__ void build_phase(const Params& p, int ph, Phase& P) {
    unsigned char* ws = p.ws; float* X = p.out + O_Y;
    P.ng = 0; P.a0 = P.a1 = P.a2 = 0; P.type = PT_PREP;
    if (ph == 0) return;
    int q = ph - 1, layer, step;
    if (q < 12) { layer = 0; step = q; } else if (q < 25) { layer = 1; step = q - 12; } else if (q < 36) { layer = 2; step = q - 25; } else { layer = 3; step = q - 36; }
    const int kind = layer % 3, j = layer / 3;
    const int nmix = kind == 0 ? 4 : (kind == 1 ? 5 : 3);
    const bf16_t* ffn_in0 = (const bf16_t*)(ws + W_FFN_IN) + (size_t)(layer * 2) * 5632 * 1024;
    const bf16_t* ffn_out0 = (const bf16_t*)(ws + W_FFN_OUT) + (size_t)(layer * 2) * 1024 * 2816;
    if (step == 0) { P.type = PT_GEMM; P.ng = 1; P.g[0] = mk(ws + A_XBALT, 1024, ffn_in0, 1024, 1024, 5632, EK_FFN1, nullptr, ws + A_ACT, nullptr, nullptr, nullptr, 0.f, 0, MT / BM); return; }
    if (step == 1) { P.type = PT_GEMM; P.ng = 1; P.g[0] = mk(ws + A_ACT, DFF, ffn_out0, DFF, DFF, 1024, EK_RES, X, nullptr, nullptr, nullptr, nullptr, 0.5f, 0); return; }
    if (step == 2) { P.type = PT_LN; P.a0 = layer; P.a1 = 0; P.a2 = 0; return; }
    const int ms = step - 3;
    if (ms < nmix) {
        if (kind == 0) {
            if (ms == 0) { P.type = PT_GEMM; P.ng = 1; P.g[0] = mk(ws + A_XB, 1024, (const bf16_t*)(ws + W_A_IN) + (size_t)j * 4096 * 1024, 1024, 1024, 4096, EK_GELU_UV, (float*)(ws + A_V), ws + A_U, nullptr, p.in[14] + (size_t)j * 4096, nullptr, 0.f, 0); return; }
            if (ms == 1) { P.type = PT_LNV; P.a0 = j; return; }
            if (ms == 2) { P.type = PT_SPATIAL; P.a0 = j; return; }
            P.type = PT_GEMM; P.ng = 1; P.g[0] = mk(ws + A_YB, 2048, (const bf16_t*)(ws + W_A_OUT) + (size_t)j * 1024 * 2048, 2048, 2048, 1024, EK_RES, X, nullptr, nullptr, nullptr, nullptr, 1.0f, 0); return;
        } else if (kind == 1) {
            if (ms == 0) { P.type = PT_SHIFT; return; }
            if (ms == 1) { P.type = PT_GEMM; P.ng = 1; P.g[0] = mk(ws + A_XCAT, 2048, ws + W_B_IN, 2048, 2048, 3328, EK_BIN, (float*)(ws + A_R), ws + A_T, nullptr, nullptr, nullptr, 0.f, 0, MT / BM); return; }
            if (ms == 2) { P.type = PT_GEMM; P.ng = 1; P.g[0] = mk(ws + A_T, 256, ws + W_B_L2, 256, 256, 3072, EK_BL2, (float*)(ws + A_DEC), ws + A_AA, ws + A_GG, p.in[22], p.in[25], 0.f, 0); return; }
            if (ms == 3) { P.type = PT_SCAN; return; }
            P.type = PT_GEMM; P.ng = 1; P.g[0] = mk(ws + A_OUTPRE, 1024, ws + W_B_O, 1024, 1024, 1024, EK_RES, X, nullptr, nullptr, nullptr, nullptr, 1.0f, 0); return;
        } else {
            if (ms == 0) { P.type = PT_GEMM; P.ng = 2;
                P.g[0] = mk(ws + A_XB, 1024, ws + W_C_IN, 1024, 1024, 2048, EK_CONVZ, (float*)(ws + A_Z), nullptr, nullptr, nullptr, nullptr, 0.f, 0);
                P.g[1] = mk(ws + A_XB, 1024, (const bf16_t*)(ws + W_C_IN) + (size_t)2048 * 1024, 1024, 1024, 1024, EK_STORE, (float*)(ws + A_BG), nullptr, nullptr, nullptr, nullptr, 0.f, 1024); return; }
            if (ms == 1) { P.type = PT_CONV; return; }
            P.type = PT_GEMM; P.ng = 1; P.g[0] = mk(ws + A_YC, 1024, ws + W_C_OUT, 1024, 1024, 1024, EK_RES, X, nullptr, nullptr, nullptr, nullptr, 1.0f, 0); return;
        }
    }
    const int ts = ms - nmix;
    if (ts == 0) { P.type = PT_LN; P.a0 = layer; P.a1 = 1; P.a2 = 1; return; }
    if (ts == 1) { P.type = PT_GEMM; P.ng = 2;
        P.g[0] = mk(ws + A_XB, 1024, ffn_in0 + (size_t)5632 * 1024, 1024, 1024, 5632, EK_FFN1, nullptr, ws + A_ACT, nullptr, nullptr, nullptr, 0.f, 0, MT / BM);
        P.g[1] = mk(ws + A_PB, 256, (const bf16_t*)(ws + W_PLE_P) + (size_t)layer * 1024 * 256, 256, 256, 1024, EK_STORE, (float*)(ws + A_PP), nullptr, nullptr, nullptr, nullptr, 0.f, 1024); return; }
    if (ts == 2) { P.type = PT_GEMM; P.ng = 1; P.g[0] = mk(ws + A_ACT, DFF, ffn_out0 + (size_t)1024 * 2816, DFF, DFF, 1024, EK_RES, X, nullptr, nullptr, nullptr, nullptr, 0.5f, 0); return; }
    if (ts == 3) { P.type = PT_LN; P.a0 = layer; P.a1 = 2; P.a2 = 0; return; }
    P.type = PT_GEMM; P.ng = 1; P.g[0] = mk(ws + A_XB, 1024, (const bf16_t*)(ws + W_PLE_G) + (size_t)layer * 1024 * 1024, 1024, 1024, 1024, EK_PLE, X, ws + A_XBALT, nullptr, (const float*)(ws + A_PP), nullptr, 0.f, 0);
}
constexpr int NPHASES = 1 + 12 + 13 + 11 + 12;
#ifndef PROBE_MASK
#define PROBE_MASK 0
#endif

__global__ void __launch_bounds__(512) fwd_megakernel(Params p) {
    extern __shared__ __attribute__((aligned(16))) unsigned char lds_raw[];
    LAS unsigned char* lds = (LAS unsigned char*)lds_raw;
    cg::grid_group grid = cg::this_grid();
    Phase* tab = (Phase*)(p.ws + A_TAB);
    __shared__ uint4 xb_words;
    unsigned* barw = (unsigned*)(p.ws + A_BAR);
    if (threadIdx.x == 0) xb_words = make_uint4(0u, 0u, 0u, 0u);
    if (blockIdx.x == 0) for (int i = threadIdx.x; i < XCD_BAR_WORDS; i += 512) barw[i] = 0u;
    __syncthreads();
    if (blockIdx.x == 0 && threadIdx.x < NPHASES) build_phase(p, threadIdx.x, tab[threadIdx.x]);
    for (int rep = 0; rep < ((PROBE_MASK & 4) ? 2 : 1); ++rep) { prep_phase(p, lds); grid.sync(); }
    const XcdBarrier xb = xcd_barrier_post(barw, (volatile LAS unsigned*)&xb_words);
    for (int ph = 1; ph < NPHASES; ++ph) {
        const Phase* P = tab + ph;
        const int type = uload32(&P->type);
        int nrep = 1;
        if (PROBE_MASK & 1) { if (type == PT_GEMM && uload32(&P->g[0].kind) == EK_FFN1) nrep = 2; }
        if (PROBE_MASK & 2) { if (type == PT_SCAN) nrep = 2; }
        if (PROBE_MASK & 16) { if (type == PT_LNV || type == PT_SPATIAL) nrep = 2; }
        if (PROBE_MASK & 32) { if (type == PT_SHIFT || type == PT_CONV) nrep = 2; }
        for (int rep = 0; rep < nrep; ++rep) {
        if (PROBE_MASK & 8) xcd_barrier(xb);
        switch (type) {
            case PT_GEMM: { const int ng = uload32(&P->ng); for (int gi = 0; gi < ng; ++gi) { const GemmDesc* g = &P->g[gi]; if (!((PROBE_MASK & 128) && rep == 1)) gemm_big(lds, g, !((PROBE_MASK & 256) && rep == 1)); if (!((PROBE_MASK & 64) && rep == 1)) gemm_small(lds, g); } } break;
            case PT_LN: ln_phase(p, uload32(&P->a0), uload32(&P->a1), uload32(&P->a2) != 0); break;
            case PT_SHIFT: shift_phase(p); break;
            case PT_LNV: lnv_phase(p, uload32(&P->a0)); break;
            case PT_SPATIAL: spatial_phase(p, uload32(&P->a0), lds); break;
            case PT_CONV: conv_phase(p); break;
            default: scan_phase(p, lds); break;
        }
        if (ph + 1 < NPHASES || rep + 1 < nrep) xcd_barrier(xb);
        }
    }
}

extern "C" void kernel_launch(void* const* d_in, const int* in_sizes, int n_in, void* d_out, int out_size, void* d_ws, size_t ws_size, hipStream_t stream) {
    static int grid_blocks = 0;
    if (grid_blocks == 0) {
        if (n_in != 39 || ws_size < WS_END) { fprintf(stderr, "kernel_launch: need 39 inputs and %zu bytes of workspace, got %d / %zu\n", (size_t)WS_END, n_in, ws_size); grid_blocks = -1; return; }
        int dev = 0, cus = 0, per_cu = 0;
        hipGetDevice(&dev); hipDeviceGetAttribute(&cus, hipDeviceAttributeMultiprocessorCount, dev);
        if (hipFuncSetAttribute((const void*)fwd_megakernel, hipFuncAttributeMaxDynamicSharedMemorySize, LDS_BYTES) != hipSuccess) { fprintf(stderr, "kernel_launch: hipFuncSetAttribute failed\n"); grid_blocks = -1; return; }
        hipOccupancyMaxActiveBlocksPerMultiprocessor(&per_cu, (const void*)fwd_megakernel, 512, LDS_BYTES);
        if (per_cu < 1) { fprintf(stderr, "kernel_launch: occupancy query says %d blocks per CU\n", per_cu); per_cu = 1; }
        (void)hipGetLastError();
        grid_blocks = cus;
    }
    if (grid_blocks < 0) return;
    Params p{};
    for (int i = 0; i < 39; ++i) p.in[i] = (const float*)d_in[i];
    p.out = (float*)d_out; p.ws = (unsigned char*)d_ws;
    void* args[] = {&p};
    hipError_t e = hipLaunchCooperativeKernel((const void*)fwd_megakernel, dim3(grid_blocks), dim3(512), args, LDS_BYTES, stream);
    if (e != hipSuccess) fprintf(stderr, "cooperative launch failed: %s (grid %d)\n", hipGetErrorString(e), grid_blocks);
}
```

```cpp
#include <hip/hip_runtime.h>
#include <hip/hip_cooperative_groups.h>
#include <cstdio>
namespace cg = cooperative_groups;

#define LAS __attribute__((address_space(3)))
#define GAS __attribute__((address_space(1)))
typedef unsigned short bf16_t;
typedef short bf16x8 __attribute__((ext_vector_type(8)));
typedef float f32x4 __attribute__((ext_vector_type(4)));
typedef float f32x2 __attribute__((ext_vector_type(2)));
typedef unsigned u32x4 __attribute__((ext_vector_type(4)));
typedef unsigned u32x2 __attribute__((ext_vector_type(2)));

constexpr int D = 1024, MP = 16384, MS = 512, MT = MP + MS, DFF = 2816;
constexpr float ALPHA = 1.6817928305074290f;
constexpr int BM = 256, BK = 64, HALF = 128, HTB = HALF * BK * 2, STAGE_BYTES = 8 * HTB, NXCD = 8, WGM = 8;
constexpr int LDS_BYTES = STAGE_BYTES;

constexpr size_t SZ_ROWF = (size_t)MT * 1024 * 4;
constexpr size_t W_FFN_IN = 0;
constexpr size_t W_FFN_OUT = W_FFN_IN + (size_t)8 * 5632 * 1024 * 2;
constexpr size_t W_PLE_G = W_FFN_OUT + (size_t)8 * 1024 * 2816 * 2;
constexpr size_t W_PLE_P = W_PLE_G + (size_t)4 * 1024 * 1024 * 2;
constexpr size_t W_A_IN = W_PLE_P + (size_t)4 * 1024 * 256 * 2;
constexpr size_t W_A_OUT = W_A_IN + (size_t)2 * 4096 * 1024 * 2;
constexpr size_t W_A_S = W_A_OUT + (size_t)2 * 1024 * 2048 * 2;
constexpr size_t W_B_IN = W_A_S + (size_t)2 * 8 * 128 * 128 * 2;
constexpr size_t W_B_L2 = W_B_IN + (size_t)3328 * 2048 * 2;
constexpr size_t W_B_O = W_B_L2 + (size_t)3072 * 256 * 2;
constexpr size_t W_C_IN = W_B_O + (size_t)1024 * 1024 * 2;
constexpr size_t W_C_OUT = W_C_IN + (size_t)3072 * 1024 * 2;
constexpr size_t A_XB = W_C_OUT + (size_t)1024 * 1024 * 2;
constexpr size_t A_ACT = A_XB + (size_t)MT * 1024 * 2;
constexpr size_t A_PB = A_ACT + (size_t)MT * 2816 * 2;
constexpr size_t A_PP = A_PB + (size_t)MT * 256 * 2;
constexpr size_t A_MIX = A_PP + SZ_ROWF;
constexpr size_t A_TAB = A_MIX + 4 * SZ_ROWF;
constexpr size_t A_BAR = A_TAB + 65536;
constexpr size_t WS_END = A_BAR + 16384;
constexpr size_t A_XBALT = A_MIX;
constexpr size_t A_U = A_MIX, A_V = A_MIX + (size_t)MT * 2048 * 2, A_VN = A_V + (size_t)MT * 2048 * 4, A_YB = A_ACT;
constexpr size_t A_R = A_MIX, A_DEC = A_MIX + 3 * SZ_ROWF, A_AA = A_ACT, A_GG = A_ACT + (size_t)MT * 1024 * 2, A_T = A_GG + (size_t)MT * 1024 * 2;
constexpr size_t A_XCAT = A_PP, A_YS = A_PP, A_OUTPRE = A_MIX;
constexpr size_t A_BS = A_T + (size_t)MT * 256 * 2;
constexpr size_t A_Z = A_MIX, A_BG = A_MIX + SZ_ROWF, A_YC = A_ACT;
static_assert(A_VN + (size_t)MP * 2048 * 2 <= WS_END, "mix region");

constexpr size_t O_Y = 0, O_AV = (size_t)MT * 1024, O_WKVP = O_AV + (size_t)2 * 512 * 2048, O_SHP = O_WKVP + 524288, O_CVP = O_SHP + 8192,
                 O_WKVS = O_CVP + 16384, O_SHS = O_WKVS + 8388608, O_CVS = O_SHS + 131072;

struct Params { const float* in[39]; float* out; unsigned char* ws; };
struct Ctx { int tid; unsigned char* ws; float* out; };
__device__ __forceinline__ Ctx mkctx(const Params& p) { Ctx c; c.tid = threadIdx.x; size_t z = 0; asm volatile("" : "+v"(c.tid)); asm volatile("" : "+s"(z)); c.ws = p.ws + z; c.out = p.out + z; return c; }
__device__ __forceinline__ int uload32(const void* p) { return __builtin_amdgcn_readfirstlane(*(const volatile int*)p); }
template <class T> __device__ __forceinline__ T* uloadp(const void* p) { const unsigned lo = (unsigned)uload32(p), hi = (unsigned)uload32((const char*)p + 4); return (T*)(((unsigned long long)hi << 32) | lo); }

__device__ __forceinline__ unsigned cvt_pk_bf16(float lo, float hi) { unsigned r; asm("v_cvt_pk_bf16_f32 %0, %1, %2" : "=v"(r) : "v"(lo), "v"(hi)); return r; }
__device__ __forceinline__ float bf2f(unsigned short b) { return __uint_as_float(((unsigned)b) << 16); }
__device__ __forceinline__ f32x4 bf4_to_f4(u32x2 w) { return (f32x4){__uint_as_float(w.x << 16), __uint_as_float(w.x & 0xffff0000u), __uint_as_float(w.y << 16), __uint_as_float(w.y & 0xffff0000u)}; }
__device__ __forceinline__ u32x2 f4_to_bf4(f32x4 v) { u32x2 w; w.x = cvt_pk_bf16(v[0], v[1]); w.y = cvt_pk_bf16(v[2], v[3]); return w; }
__device__ __forceinline__ float wave_sum(float v) {
#pragma unroll
    for (int o = 32; o >= 1; o >>= 1) v += __shfl_xor(v, o);
    return v; }
template <int CTRL> __device__ __forceinline__ float dppmov(float v) { return __int_as_float(__builtin_amdgcn_update_dpp(0, __float_as_int(v), CTRL, 0xF, 0xF, true)); }
__device__ __forceinline__ float red16(float v) { v += dppmov<0xB1>(v); v += dppmov<0x4E>(v); v += dppmov<0x141>(v); v += dppmov<0x140>(v); return v; }
__device__ __forceinline__ float sigmoidf_(float x) { return 1.0f / (1.0f + __expf(-x)); }
__device__ __forceinline__ float tanh_(float x) { const float e = __expf(-2.0f * fabsf(x)); const float t = (1.0f - e) / (1.0f + e); return x < 0.f ? -t : t; }
__device__ __forceinline__ float decay_(float w) { const float sp = fmaxf(-w, 0.f) + __logf(1.0f + __expf(-fabsf(w))); return __expf(-__expf(-sp - 0.5f)); }
__device__ __forceinline__ f32x2 gelu_pk(f32x2 v) {
    const f32x2 av = __builtin_elementwise_abs(v), d = av * 0.2316418882f + 1.0f;
    f32x2 t; t.x = __builtin_amdgcn_rcpf(d.x); t.y = __builtin_amdgcn_rcpf(d.y);
    f32x2 q = t * 0.5307027145f + (-0.7265760135f); q = q * t + 0.7107068705f; q = q * t + (-0.142248368f); q = q * t + 0.127414796f; q = q * t;
    const f32x2 s = (v * v) * (-0.72134752044f);
    f32x2 e; e.x = __builtin_amdgcn_exp2f(s.x); e.y = __builtin_amdgcn_exp2f(s.y);
    const f32x2 m = v * (q * e), r = v - m;
    f32x2 o; o.x = v.x < 0.f ? m.x : r.x; o.y = v.y < 0.f ? m.y : r.y; return o;
}
__device__ __forceinline__ f32x4 gelu4(f32x4 v) { f32x2 a = gelu_pk((f32x2){v[0], v[1]}), b = gelu_pk((f32x2){v[2], v[3]}); return (f32x4){a.x, a.y, b.x, b.y}; }

enum { EK_FFN1 = 0, EK_RES, EK_GELU_UV, EK_STORE, EK_CONVZ, EK_PLE, EK_BIN, EK_BL2 };
struct alignas(16) GemmDesc {
    const bf16_t* A; const bf16_t* Bt;
    int lda, ldb, K, nN;
    int kind, nM, ld; float scale;
    float* f0; bf16_t* h0;
    bf16_t* h1; const float* c0;
    const float* c1; long long pad;
};
struct EpiG { int kind; GAS float* f0; GAS bf16_t* h0; GAS bf16_t* h1; const GAS float* c0; const GAS float* c1; float scale; int ld; };
__device__ __forceinline__ void uload_x4(const GAS u32x4* p, unsigned (&o)[4]) { const u32x4 v = *p; o[0] = (unsigned)__builtin_amdgcn_readfirstlane((int)v.x); o[1] = (unsigned)__builtin_amdgcn_readfirstlane((int)v.y); o[2] = (unsigned)__builtin_amdgcn_readfirstlane((int)v.z); o[3] = (unsigned)__builtin_amdgcn_readfirstlane((int)v.w); }
__device__ __forceinline__ unsigned long long mk64(unsigned lo, unsigned hi) { return ((unsigned long long)hi << 32) | lo; }
struct GemmHead { const GAS bf16_t* A; const GAS bf16_t* Bt; int lda, ldb, K, nN, kind, nM; };
__device__ __forceinline__ GemmHead load_head(const GemmDesc* gd) {
    const GemmDesc* g2 = gd; asm volatile("" : "+s"(g2)); const GAS u32x4* q = (const GAS u32x4*)g2; unsigned a[4], b[4], c[4]; uload_x4(q, a); uload_x4(q + 1, b); uload_x4(q + 2, c);
    GemmHead h; h.A = (const GAS bf16_t*)mk64(a[0], a[1]); h.Bt = (const GAS bf16_t*)mk64(a[2], a[3]); h.lda = (int)b[0]; h.ldb = (int)b[1]; h.K = (int)b[2]; h.nN = (int)b[3]; h.kind = (int)c[0]; h.nM = (int)c[1]; return h; }
__device__ __forceinline__ EpiG load_epi(const GemmDesc* gd) {
    const GemmDesc* g2 = gd; asm volatile("" : "+s"(g2)); const GAS u32x4* q = (const GAS u32x4*)g2; unsigned c[4], d[4], e4[4], f[4]; uload_x4(q + 2, c); uload_x4(q + 3, d); uload_x4(q + 4, e4); uload_x4(q + 5, f);
    EpiG e; e.kind = (int)c[0]; e.ld = (int)c[2]; e.scale = __uint_as_float(c[3]); e.f0 = (GAS float*)mk64(d[0], d[1]); e.h0 = (GAS bf16_t*)mk64(d[2], d[3]); e.h1 = (GAS bf16_t*)mk64(e4[0], e4[1]);
    e.c0 = (const GAS float*)mk64(e4[2], e4[3]); e.c1 = (const GAS float*)mk64(f[0], f[1]); return e; }

template <int KIND> __device__ __forceinline__ void epi_elem(const EpiG& e, int row, int col, f32x4 v0, f32x4 v1) {
    if (KIND == EK_FFN1) {
        f32x4 o;
#pragma unroll
        for (int j = 0; j < 4; ++j) o[j] = v0[j] * __builtin_amdgcn_rcpf(1.0f + __expf(-v0[j])) * v1[j];
        *(GAS u32x2*)(e.h0 + (size_t)row * DFF + col) = f4_to_bf4(o);
    } else if (KIND == EK_RES) {
        GAS float* p = e.f0 + (size_t)row * 1024 + col; const f32x4 x = *(const f32x4*)p; *(f32x4*)p = x * ALPHA + v0 * e.scale;
    } else if (KIND == EK_GELU_UV) {
        const f32x4 b = *(const GAS f32x4*)(e.c0 + col); const f32x4 g = gelu4(v0 + b);
        if (col < 2048) *(GAS u32x2*)(e.h0 + (size_t)row * 2048 + col) = f4_to_bf4(g);
        else *(GAS f32x4*)(e.f0 + (size_t)row * 2048 + (col - 2048)) = g;
    } else if (KIND == EK_STORE) {
        *(GAS f32x4*)(e.f0 + (size_t)row * e.ld + col) = v0;
    } else if (KIND == EK_CONVZ) {
        *(GAS f32x4*)(e.f0 + (size_t)row * 1024 + col) = v0 * v1;
    } else if (KIND == EK_PLE) {
        GAS float* p = e.f0 + (size_t)row * 1024 + col; f32x4 x = *(const f32x4*)p; const f32x4 pp = *(const GAS f32x4*)(e.c0 + (size_t)row * 1024 + col);
#pragma unroll
        for (int j = 0; j < 4; ++j) x[j] += pp[j] * __builtin_amdgcn_rcpf(1.0f + __expf(-v0[j]));
        *(f32x4*)p = x; *(GAS u32x2*)(e.h0 + (size_t)row * 1024 + col) = f4_to_bf4(x);
    } else if (KIND == EK_BIN) {
        if (col < 3072) { const int t = col >> 10; *(GAS f32x4*)(e.f0 + (size_t)t * ((size_t)MT * 1024) + (size_t)row * 1024 + (col & 1023)) = v0; }
        else { const int c = col - 3072; f32x4 o;
            if (c < 64) { o[0] = tanh_(v0[0]); o[1] = tanh_(v0[1]); o[2] = tanh_(v0[2]); o[3] = tanh_(v0[3]); }
            else if (c < 128) o = v0;
            else { o[0] = sigmoidf_(v0[0]); o[1] = sigmoidf_(v0[1]); o[2] = sigmoidf_(v0[2]); o[3] = sigmoidf_(v0[3]); }
            *(GAS u32x2*)(e.h0 + (size_t)row * 256 + c) = f4_to_bf4(o); }
    } else if (KIND == EK_BL2) {
        if (col < 1024) { const f32x4 w0 = *(const GAS f32x4*)(e.c0 + col); f32x4 o;
#pragma unroll
            for (int j = 0; j < 4; ++j) o[j] = decay_(w0[j] + v0[j]);
            *(GAS f32x4*)(e.f0 + (size_t)row * 1024 + col) = o;
        } else if (col < 2048) { const int c = col - 1024; const f32x4 a0 = *(const GAS f32x4*)(e.c1 + c); f32x4 o;
#pragma unroll
            for (int j = 0; j < 4; ++j) o[j] = sigmoidf_(a0[j] + v0[j]);
            *(GAS u32x2*)(e.h0 + (size_t)row * 1024 + c) = f4_to_bf4(o);
        } else { *(GAS u32x2*)(e.h1 + (size_t)row * 1024 + (col - 2048)) = f4_to_bf4(v0); }
    }
}
template <int KIND> __device__ __forceinline__ void epi_big(const GemmDesc* gd, const f32x4 (&acc)[2][2][4][2], int pm, int pn, int wr, int wc, int fr, int fq) {
    constexpr bool PAIRED = (KIND == EK_FFN1 || KIND == EK_CONVZ);
    const EpiG e = load_epi(gd);
#pragma unroll
    for (int ai = 0; ai < 2; ++ai)
#pragma unroll
        for (int m = 0; m < 4; ++m) {
            if (m & 1) asm volatile("" ::: "memory");
            const int row = pm * BM + ai * HALF + wr * 64 + m * 16 + fr;
#pragma unroll
            for (int n = 0; n < 2; ++n) {
                if (PAIRED) epi_elem<KIND>(e, row, pn * 128 + wc * 32 + n * 16 + fq * 4, acc[ai][0][m][n], acc[ai][1][m][n]);
                else {
#pragma unroll
                    for (int bj = 0; bj < 2; ++bj) epi_elem<KIND>(e, row, pn * BM + bj * HALF + wc * 32 + n * 16 + fq * 4, acc[ai][bj][m][n], acc[ai][bj][m][n]);
                }
            }
        }
}

__device__ __forceinline__ int lds_byte(int r, int c) { const int st = (r >> 4) * 2 + (c >> 5), rr = r & 15, cc = c & 31, ob = rr * 64 + cc * 2; return st * 1024 + (ob ^ (((ob >> 9) & 1) << 5)); }
__device__ __forceinline__ void stage_rc(int b, int& R, int& C) { const int st = b / 1024, sb = b % 1024, swz = sb ^ (((sb >> 9) & 1) << 5); R = (st >> 1) * 16 + swz / 64; C = (st & 1) * 32 + (swz % 64) / 2; }
struct Unit { int pm, pn; };
struct StaticOrder {
    int nM, nN, nwg, G, c;
    __device__ void init(int nM_, int nN_, int G_, int c_) { nM = nM_; nN = nN_; nwg = nM * nN; G = G_; c = c_; }
    __device__ bool next(int i, Unit& u) const {
        const long L = (long)i * G + c; if (L >= nwg) return false;
        int wgid = (int)L; { const int q = nwg / NXCD, r = nwg % NXCD, xcd = wgid % NXCD, off = wgid / NXCD; wgid = (xcd < r ? xcd * (q + 1) : r * (q + 1) + (xcd - r) * q) + off; }
        const int nig = WGM * nN, gid = wgid / nig, fm = gid * WGM, gsz = (nM - fm) < WGM ? (nM - fm) : WGM;
        u.pm = fm + ((wgid % nig) % gsz); u.pn = (wgid % nig) / gsz; return true;
    }
};

__device__ __forceinline__ void gemm_big(LAS unsigned char* lds, const GemmDesc* gd, const bool do_epi = true) {
    int tid_ = threadIdx.x; asm volatile("" : "+v"(tid_));
    const int tid = tid_, wid = __builtin_amdgcn_readfirstlane(tid >> 6), lane = tid & 63, wr = wid >> 2, wc = wid & 3, fr = lane & 15, fq = lane >> 4;
    const GemmHead g = load_head(gd);
    const int ekind = g.kind;
    const int K = g.K, nt = K / BK;
    StaticOrder S; S.init(g.nM, g.nN, gridDim.x, blockIdx.x);
    unsigned voffA[2], voffB[2];
#pragma unroll
    for (int i = 0; i < 2; ++i) { int R, C; stage_rc(tid * 16 + i * 8192, R, C); voffA[i] = (unsigned)(R * g.lda + C) * 2u; voffB[i] = (unsigned)(R * g.ldb + C) * 2u; }
    const size_t kstep = (size_t)(BK * 2);
    const size_t hstepA = (size_t)HALF * g.lda * 2, hstepB = (size_t)HALF * g.ldb * 2;
    const size_t tstepA = 2 * hstepA, tstepB = 2 * hstepB;
    const unsigned ldsw = (unsigned)wid * 1024u;
    const int aoff = lds_byte(wr * 64 + fr, fq * 8), boff = lds_byte(wc * 32 + fr, fq * 8);
#define PG8_SA(b, h) (((b) * 2 + (h)) * HTB)
#define PG8_SB(b, h) ((4 + (b) * 2 + (h)) * HTB)
#define PG8_STAGE(bufoff, gbase, voff) do { _Pragma("unroll") for (int _i = 0; _i < 2; ++_i) \
        __builtin_amdgcn_global_load_lds((const unsigned*)((const char*)(gbase) + (voff)[_i]), (LAS unsigned*)(lds + (bufoff) + ldsw + _i * 8192), 16, 0, 0); } while (0)
#define PG8_LDA(dst, b, h) do { _Pragma("unroll") for (int m = 0; m < 4; ++m) _Pragma("unroll") for (int k = 0; k < 2; ++k) dst[m][k] = *(const LAS bf16x8*)(lds + PG8_SA(b, h) + aoff + m * 2048 + k * 1024); } while (0)
#define PG8_LDB(dst, b, h) do { _Pragma("unroll") for (int n = 0; n < 2; ++n) _Pragma("unroll") for (int k = 0; k < 2; ++k) dst[n][k] = *(const LAS bf16x8*)(lds + PG8_SB(b, h) + boff + n * 2048 + k * 1024); } while (0)
#define PG8_MMA(ai, bj, At, Bt) do { __builtin_amdgcn_s_setprio(1); _Pragma("unroll") for (int m = 0; m < 4; ++m) _Pragma("unroll") for (int n = 0; n < 2; ++n) _Pragma("unroll") for (int k = 0; k < 2; ++k) \
        acc[ai][bj][m][n] = __builtin_amdgcn_mfma_f32_16x16x32_bf16(Bt[n][k], At[m][k], acc[ai][bj][m][n], 0, 0, 0); __builtin_amdgcn_s_setprio(0); } while (0)
#define PG8_WAIT_V(n) asm volatile("s_waitcnt vmcnt(" #n ")" ::: "memory")
#define PG8_WAIT_L(n) asm volatile("s_waitcnt lgkmcnt(" #n ")" ::: "memory")
#define PG8_BAR __builtin_amdgcn_s_barrier()
#define PG8_SCHED __builtin_amdgcn_sched_barrier(0)
    Unit cur, nxt; int ui = 0;
    if (!S.next(0, cur)) return;
    f32x4 acc[2][2][4][2];
#pragma unroll
    for (int a = 0; a < 2; ++a)
#pragma unroll
        for (int b = 0; b < 2; ++b)
#pragma unroll
            for (int m = 0; m < 4; ++m)
#pragma unroll
                for (int n = 0; n < 2; ++n) acc[a][b][m][n] = (f32x4){0.f, 0.f, 0.f, 0.f};
    bf16x8 At[4][2], B0[2][2], B1[2][2];
    const char* cA = (const char*)g.A + (size_t)cur.pm * tstepA; const char* cB = (const char*)g.Bt + (size_t)cur.pn * tstepB;
    PG8_STAGE(PG8_SB(0, 0), cB, voffB); PG8_STAGE(PG8_SA(0, 0), cA, voffA); PG8_STAGE(PG8_SB(0, 1), cB + hstepB, voffB); PG8_STAGE(PG8_SA(0, 1), cA + hstepA, voffA);
    if (wr == 1) PG8_BAR;
    PG8_WAIT_V(4); PG8_BAR;
    PG8_STAGE(PG8_SB(1, 0), cB + kstep, voffB); PG8_STAGE(PG8_SA(1, 0), cA + kstep, voffA); PG8_STAGE(PG8_SB(1, 1), cB + hstepB + kstep, voffB);
    PG8_WAIT_V(6); PG8_BAR;
    for (;;) {
        const bool has_next = S.next(ui + 1, nxt);
        const char* nA = has_next ? (const char*)g.A + (size_t)nxt.pm * tstepA : cA; const char* nB = has_next ? (const char*)g.Bt + (size_t)nxt.pn * tstepB : cB;
        for (int t = 0; t < nt; t += 2) {
            const bool last = (t == nt - 2);
            const char* a1 = cA + (size_t)(t + 1) * kstep;
            const char* a2 = last ? nA : cA + (size_t)(t + 2) * kstep; const char* b2 = last ? nB : cB + (size_t)(t + 2) * kstep;
            const char* a3 = a2 + kstep; const char* b3 = b2 + kstep;
            PG8_LDB(B0, 0, 0); PG8_SCHED; PG8_LDA(At, 0, 0); PG8_STAGE(PG8_SA(1, 1), a1 + hstepA, voffA);
            PG8_WAIT_L(8); PG8_BAR; PG8_WAIT_L(0); PG8_MMA(0, 0, At, B0); PG8_BAR; PG8_SCHED;
            PG8_LDB(B1, 0, 1); PG8_STAGE(PG8_SB(0, 0), b2, voffB);
            PG8_BAR; PG8_WAIT_L(0); PG8_MMA(0, 1, At, B1); PG8_BAR;
            PG8_LDA(At, 0, 1); PG8_STAGE(PG8_SA(0, 0), a2, voffA);
            PG8_BAR; PG8_WAIT_L(0); PG8_MMA(1, 0, At, B0); PG8_BAR; PG8_SCHED;
            PG8_STAGE(PG8_SB(0, 1), b2 + hstepB, voffB);
            PG8_WAIT_V(6); PG8_BAR; PG8_MMA(1, 1, At, B1); PG8_BAR;
            PG8_LDB(B0, 1, 0); PG8_SCHED; PG8_LDA(At, 1, 0); PG8_STAGE(PG8_SA(0, 1), a2 + hstepA, voffA);
            PG8_WAIT_L(8); PG8_BAR; PG8_WAIT_L(0); PG8_MMA(0, 0, At, B0); PG8_BAR; PG8_SCHED;
            PG8_LDB(B1, 1, 1); PG8_STAGE(PG8_SB(1, 0), b3, voffB);
            PG8_BAR; PG8_WAIT_L(0); PG8_MMA(0, 1, At, B1); PG8_BAR;
            PG8_LDA(At, 1, 1); PG8_STAGE(PG8_SA(1, 0), a3, voffA);
            PG8_BAR; PG8_WAIT_L(0); PG8_MMA(1, 0, At, B0); PG8_BAR; PG8_SCHED;
            PG8_STAGE(PG8_SB(1, 1), b3 + hstepB, voffB);
            PG8_WAIT_V(6); PG8_BAR; PG8_MMA(1, 1, At, B1); PG8_BAR;
        }
        if (do_epi) switch (ekind) {
            case EK_FFN1: epi_big<EK_FFN1>(gd, acc, cur.pm, cur.pn, wr, wc, fr, fq); break;
            case EK_RES: epi_big<EK_RES>(gd, acc, cur.pm, cur.pn, wr, wc, fr, fq); break;
            case EK_GELU_UV: epi_big<EK_GELU_UV>(gd, acc, cur.pm, cur.pn, wr, wc, fr, fq); break;
            case EK_STORE: epi_big<EK_STORE>(gd, acc, cur.pm, cur.pn, wr, wc, fr, fq); break;
            case EK_CONVZ: epi_big<EK_CONVZ>(gd, acc, cur.pm, cur.pn, wr, wc, fr, fq); break;
            case EK_PLE: epi_big<EK_PLE>(gd, acc, cur.pm, cur.pn, wr, wc, fr, fq); break;
            case EK_BIN: epi_big<EK_BIN>(gd, acc, cur.pm, cur.pn, wr, wc, fr, fq); break;
            default: epi_big<EK_BL2>(gd, acc, cur.pm, cur.pn, wr, wc, fr, fq); break;
        }
        if (!has_next) break;
#pragma unroll
        for (int a = 0; a < 2; ++a)
#pragma unroll
            for (int b = 0; b < 2; ++b)
#pragma unroll
                for (int m = 0; m < 4; ++m)
#pragma unroll
                    for (int n = 0; n < 2; ++n) acc[a][b][m][n] = (f32x4){0.f, 0.f, 0.f, 0.f};
        cur = nxt; cA = nA; cB = nB; ++ui;
    }
    PG8_WAIT_V(0);
    if (wr == 0) PG8_BAR;
    PG8_BAR;
#undef PG8_SA
#undef PG8_SB
#undef PG8_STAGE
#undef PG8_LDA
#undef PG8_LDB
#undef PG8_MMA
#undef PG8_WAIT_V
#undef PG8_WAIT_L
#undef PG8_BAR
#undef PG8_SCHED
}

template <int KIND> __device__ __forceinline__ void small_epi(const EpiG& e, int row, int col, f32x4 v0, f32x4 v1) { epi_elem<KIND>(e, row, col, v0, v1); }
__device__ __forceinline__ void gemm_small(LAS unsigned char* lds, const GemmDesc* gd) {
    int tid_ = threadIdx.x; asm volatile("" : "+v"(tid_));
    const int tid = tid_, wid = __builtin_amdgcn_readfirstlane(tid >> 6), lane = tid & 63, fr = lane & 15, fq = lane >> 4;
    const GemmHead g = load_head(gd);
    if (g.nM != MP / BM) return;
    const int ekind = g.kind;
    const bool paired = (ekind == EK_FFN1 || ekind == EK_CONVZ);
    const int ncu = paired ? g.nN * 4 : g.nN * 4;
    const int nunits = 8 * ncu;
    const int kq = wid >> 1, nh = wid & 1;
    const int ks = g.K >> 2;
    LAS f32x4* P = (LAS f32x4*)lds;
    for (int su = (int)(gridDim.x - 1 - blockIdx.x); su < nunits; su += gridDim.x) {
        const int rp = su & 7, cu = su >> 3;
        const int row0 = MP + rp * 64;
        int brow[2];
#pragma unroll
        for (int j = 0; j < 2; ++j) { const int nb = nh * 2 + j;
            if (paired) { const int p0 = cu * 32; brow[j] = (p0 >> 7) * 256 + (nb >> 1) * 128 + (p0 & 127) + (nb & 1) * 16 + fr; }
            else brow[j] = cu * 64 + nb * 16 + fr; }
        const GAS bf16_t* ap = g.A + (size_t)(row0 + fr) * g.lda + kq * ks + fq * 8;
        const GAS bf16_t* bp0 = g.Bt + (size_t)brow[0] * g.ldb + kq * ks + fq * 8;
        const GAS bf16_t* bp1 = g.Bt + (size_t)brow[1] * g.ldb + kq * ks + fq * 8;
        f32x4 acc[4][2];
#pragma unroll
        for (int m = 0; m < 4; ++m) { acc[m][0] = (f32x4){0.f, 0.f, 0.f, 0.f}; acc[m][1] = (f32x4){0.f, 0.f, 0.f, 0.f}; }
#pragma unroll 2
        for (int k = 0; k < ks; k += 32) {
            bf16x8 a[4], b[2];
#pragma unroll
            for (int m = 0; m < 4; ++m) a[m] = *(const GAS bf16x8*)(ap + (size_t)(m * 16) * g.lda + k);
            b[0] = *(const GAS bf16x8*)(bp0 + k); b[1] = *(const GAS bf16x8*)(bp1 + k);
#pragma unroll
            for (int m = 0; m < 4; ++m) { acc[m][0] = __builtin_amdgcn_mfma_f32_16x16x32_bf16(b[0], a[m], acc[m][0], 0, 0, 0); acc[m][1] = __builtin_amdgcn_mfma_f32_16x16x32_bf16(b[1], a[m], acc[m][1], 0, 0, 0); }
        }
#pragma unroll
        for (int m = 0; m < 4; ++m)
#pragma unroll
            for (int j = 0; j < 2; ++j) P[((kq * 4 + m) * 4 + nh * 2 + j) * 64 + lane] = acc[m][j];
        __syncthreads();
        {   const int m = wid >> 1, s = wid & 1;
            f32x4 v0 = (f32x4){0.f, 0.f, 0.f, 0.f}, v1 = v0;
#pragma unroll
            for (int q = 0; q < 4; ++q) { v0 += P[((q * 4 + m) * 4 + s) * 64 + lane]; v1 += P[((q * 4 + m) * 4 + s + 2) * 64 + lane]; }
            const int row = row0 + m * 16 + fr;
            const int cA_ = paired ? cu * 32 + s * 16 + fq * 4 : cu * 64 + s * 16 + fq * 4;
            const int cB_ = cu * 64 + (s + 2) * 16 + fq * 4;
            const EpiG e = load_epi(gd);
            switch (ekind) {
                case EK_FFN1: small_epi<EK_FFN1>(e, row, cA_, v0, v1); break;
                case EK_CONVZ: small_epi<EK_CONVZ>(e, row, cA_, v0, v1); break;
                case EK_RES: small_epi<EK_RES>(e, row, cA_, v0, v0); small_epi<EK_RES>(e, row, cB_, v1, v1); break;
                case EK_GELU_UV: small_epi<EK_GELU_UV>(e, row, cA_, v0, v0); small_epi<EK_GELU_UV>(e, row, cB_, v1, v1); break;
                case EK_STORE: small_epi<EK_STORE>(e, row, cA_, v0, v0); small_epi<EK_STORE>(e, row, cB_, v1, v1); break;
                case EK_PLE: small_epi<EK_PLE>(e, row, cA_, v0, v0); small_epi<EK_PLE>(e, row, cB_, v1, v1); break;
                case EK_BIN: small_epi<EK_BIN>(e, row, cA_, v0, v0); small_epi<EK_BIN>(e, row, cB_, v1, v1); break;
                default: small_epi<EK_BL2>(e, row, cA_, v0, v0); small_epi<EK_BL2>(e, row, cB_, v1, v1); break;
            }
        }
        __syncthreads();
    }
}

__device__ __forceinline__ int srccol(int mode, int n0) {
    if (mode == 1) { const int pn = n0 >> 8, bj = (n0 >> 7) & 1, l = n0 & 127; return bj * DFF + pn * 128 + l; }
    if (mode == 2) { if (n0 < 2048) { const int pn = n0 >> 8, bj = (n0 >> 7) & 1, l = n0 & 127; return 1024 * (1 + bj) + pn * 128 + l; } return n0 - 2048; }
    return n0;
}
__device__ __forceinline__ void tconv(LAS float* tile, int& base, const float* src, int ld, int K, int ncols, bf16_t* dst, int ldd, int koff, int mode, const float* scale) {
    int tid_ = threadIdx.x; asm volatile("" : "+v"(tid_));
    const int nkt = K >> 6, ntl = nkt * (ncols >> 6), G = gridDim.x, tid = tid_;
    int t0 = ((int)blockIdx.x - (base % G) + G) % G; base += ntl;
    for (int t = t0; t < ntl; t += G) {
        const int kt = t % nkt, n0 = (t / nkt) * 64, k0 = kt * 64, sc0 = srccol(mode, n0);
        __syncthreads();
#pragma unroll
        for (int i = 0; i < 2; ++i) { const int kk = (tid >> 4) + i * 32, n4 = (tid & 15) * 4;
            f32x4 v = *(const f32x4*)(src + (size_t)(k0 + kk) * ld + sc0 + n4);
            if (scale) v = v * scale[k0 + kk];
#pragma unroll
            for (int j = 0; j < 4; ++j) tile[kk * 65 + n4 + j] = v[j]; }
        __syncthreads();
        { const int nn = tid >> 3, k8 = (tid & 7) * 8; u32x4 w;
            w.x = cvt_pk_bf16(tile[(k8 + 0) * 65 + nn], tile[(k8 + 1) * 65 + nn]); w.y = cvt_pk_bf16(tile[(k8 + 2) * 65 + nn], tile[(k8 + 3) * 65 + nn]);
            w.z = cvt_pk_bf16(tile[(k8 + 4) * 65 + nn], tile[(k8 + 5) * 65 + nn]); w.w = cvt_pk_bf16(tile[(k8 + 6) * 65 + nn], tile[(k8 + 7) * 65 + nn]);
            *(u32x4*)(dst + (size_t)(n0 + nn) * ldd + koff + k0 + k8) = w; }
    }
}
__device__ __forceinline__ void prep_phase(const Params& p, LAS unsigned char* lds) {
    const Ctx cx = mkctx(p);
    LAS float* tile = (LAS float*)lds; unsigned char* ws = cx.ws; int base = 0;
    const size_t gt = (size_t)blockIdx.x * 512 + cx.tid, gn = (size_t)gridDim.x * 512;
    for (int q = 0; q < 8; ++q) tconv(tile, base, p.in[9] + (size_t)q * 1024 * 5632, 5632, 1024, 5632, (bf16_t*)(ws + W_FFN_IN) + (size_t)q * 5632 * 1024, 1024, 0, 1, nullptr);
    for (int q = 0; q < 8; ++q) tconv(tile, base, p.in[10] + (size_t)q * 2816 * 1024, 1024, 2816, 1024, (bf16_t*)(ws + W_FFN_OUT) + (size_t)q * 1024 * 2816, 2816, 0, 0, nullptr);
    for (int i = 0; i < 4; ++i) tconv(tile, base, p.in[11] + (size_t)i * 1024 * 1024, 1024, 1024, 1024, (bf16_t*)(ws + W_PLE_G) + (size_t)i * 1024 * 1024, 1024, 0, 0, nullptr);
    for (int i = 0; i < 4; ++i) tconv(tile, base, p.in[12] + (size_t)i * 256 * 1024, 1024, 256, 1024, (bf16_t*)(ws + W_PLE_P) + (size_t)i * 1024 * 256, 256, 0, 0, nullptr);
    for (int j = 0; j < 2; ++j) tconv(tile, base, p.in[13] + (size_t)j * 1024 * 4096, 4096, 1024, 4096, (bf16_t*)(ws + W_A_IN) + (size_t)j * 4096 * 1024, 1024, 0, 0, nullptr);
    for (int j = 0; j < 2; ++j) tconv(tile, base, p.in[19] + (size_t)j * 2048 * 1024, 1024, 2048, 1024, (bf16_t*)(ws + W_A_OUT) + (size_t)j * 1024 * 2048, 2048, 0, 0, nullptr);
    bf16_t* bin = (bf16_t*)(ws + W_B_IN);
    for (int q = 0; q < 3; ++q) { const int mi = q == 0 ? 0 : (q == 1 ? 2 : 3);
        tconv(tile, base, p.in[21] + (size_t)q * 1024 * 1024, 1024, 1024, 1024, bin + (size_t)q * 1024 * 2048, 2048, 0, 0, nullptr);
        tconv(tile, base, p.in[21] + (size_t)q * 1024 * 1024, 1024, 1024, 1024, bin + (size_t)q * 1024 * 2048, 2048, 1024, 0, p.in[20] + mi * 1024); }
    tconv(tile, base, p.in[23], 64, 1024, 64, bin + (size_t)3072 * 2048, 2048, 0, 0, nullptr);
    tconv(tile, base, p.in[23], 64, 1024, 64, bin + (size_t)3072 * 2048, 2048, 1024, 0, p.in[20] + 1 * 1024);
    tconv(tile, base, p.in[26], 64, 1024, 64, bin + (size_t)3136 * 2048, 2048, 0, 0, nullptr);
    tconv(tile, base, p.in[26], 64, 1024, 64, bin + (size_t)3136 * 2048, 2048, 1024, 0, p.in[20] + 4 * 1024);
    tconv(tile, base, p.in[28], 128, 1024, 128, bin + (size_t)3200 * 2048, 2048, 0, 0, nullptr);
    tconv(tile, base, p.in[28], 128, 1024, 128, bin + (size_t)3200 * 2048, 2048, 1024, 0, p.in[20] + 5 * 1024);
    tconv(tile, base, p.in[35], 1024, 1024, 1024, (bf16_t*)(ws + W_B_O), 1024, 0, 0, nullptr);
    tconv(tile, base, p.in[36], 3072, 1024, 3072, (bf16_t*)(ws + W_C_IN), 1024, 0, 2, nullptr);
    tconv(tile, base, p.in[38], 1024, 1024, 1024, (bf16_t*)(ws + W_C_OUT), 1024, 0, 0, nullptr);
    { bf16_t* l2 = (bf16_t*)(ws + W_B_L2);
        for (size_t i = gt; i < (size_t)3072 * 256; i += gn) { const int n = (int)(i >> 8), k = (int)(i & 255); float v = 0.f;
            if (n < 1024) { if (k < 64) v = p.in[24][k * 1024 + n]; }
            else if (n < 2048) { if (k >= 64 && k < 128) v = p.in[27][(k - 64) * 1024 + (n - 1024)]; }
            else { if (k >= 128) v = p.in[29][(k - 128) * 1024 + (n - 2048)]; }
            l2[i] = (bf16_t)(cvt_pk_bf16(v, 0.f) & 0xffffu); } }
    { bf16_t* as = (bf16_t*)(ws + W_A_S);
        for (size_t i = gt; i < (size_t)2 * 8 * 128 * 128; i += gn) { const int s = (int)(i & 127), t = (int)((i >> 7) & 127); const float v = s <= t ? p.in[17][i] : 0.f; as[i] = (bf16_t)(cvt_pk_bf16(v, 0.f) & 0xffffu); } }
    { float* X = cx.out + O_Y; bf16_t* xb = (bf16_t*)(ws + A_XBALT);
        for (size_t i = gt; i < (size_t)MT * 256; i += gn) { const size_t e = i * 4; const f32x4 v = e < (size_t)MP * 1024 ? *(const f32x4*)(p.in[0] + e) : *(const f32x4*)(p.in[1] + (e - (size_t)MP * 1024));
            *(f32x4*)(X + e) = v; *(u32x2*)(xb + e) = f4_to_bf4(v); } }
}

__device__ __forceinline__ void ln_phase(const Params& p, int layer, int which, bool write_pb) {
    const Ctx cx = mkctx(p);
    const int lane = cx.tid & 63, gw = blockIdx.x * 8 + (cx.tid >> 6), nw = gridDim.x * 8;
    float* X = cx.out + O_Y; bf16_t* xb = (bf16_t*)(cx.ws + A_XB);
    const float* g = p.in[7] + (size_t)(layer * 3 + which) * 1024; const float* b = p.in[8] + (size_t)(layer * 3 + which) * 1024;
    f32x4 gv[4], bv[4];
#pragma unroll
    for (int i = 0; i < 4; ++i) { gv[i] = *(const f32x4*)(g + i * 256 + lane * 4); bv[i] = *(const f32x4*)(b + i * 256 + lane * 4); }
    for (int rq = gw; rq < MT / 4; rq += nw) {
        f32x4 v[4][4]; float sm[4];
#pragma unroll
        for (int r = 0; r < 4; ++r) { sm[r] = 0.f;
#pragma unroll
            for (int i = 0; i < 4; ++i) { v[r][i] = *(const f32x4*)(X + (size_t)(rq * 4 + r) * 1024 + i * 256 + lane * 4); sm[r] += (v[r][i][0] + v[r][i][1]) + (v[r][i][2] + v[r][i][3]); } }
#pragma unroll
        for (int o = 32; o >= 1; o >>= 1) {
#pragma unroll
            for (int r = 0; r < 4; ++r) sm[r] += __shfl_xor(sm[r], o); }
        float qq[4];
#pragma unroll
        for (int r = 0; r < 4; ++r) { const float mean = sm[r] * (1.0f / 1024.0f); qq[r] = 0.f;
#pragma unroll
            for (int i = 0; i < 4; ++i) { v[r][i] = v[r][i] - mean; qq[r] += (v[r][i][0] * v[r][i][0] + v[r][i][1] * v[r][i][1]) + (v[r][i][2] * v[r][i][2] + v[r][i][3] * v[r][i][3]); } }
#pragma unroll
        for (int o = 32; o >= 1; o >>= 1) {
#pragma unroll
            for (int r = 0; r < 4; ++r) qq[r] += __shfl_xor(qq[r], o); }
#pragma unroll
        for (int r = 0; r < 4; ++r) { const float rstd = rsqrtf(qq[r] * (1.0f / 1024.0f) + 1e-5f); const size_t ro = (size_t)(rq * 4 + r) * 1024;
#pragma unroll
            for (int i = 0; i < 4; ++i) { const f32x4 y = v[r][i] * rstd * gv[i] + bv[i]; *(f32x4*)(X + ro + i * 256 + lane * 4) = y; *(u32x2*)(xb + ro + i * 256 + lane * 4) = f4_to_bf4(y); } }
    }
    if (write_pb) { bf16_t* pb = (bf16_t*)(cx.ws + A_PB); const size_t gt = (size_t)blockIdx.x * 512 + cx.tid, gn = (size_t)gridDim.x * 512;
        for (size_t i = gt; i < (size_t)MT * 64; i += gn) { const size_t e = i * 4; const f32x4 v = e < (size_t)MP * 256 ? *(const f32x4*)(p.in[5] + (size_t)layer * MP * 256 + e) : *(const f32x4*)(p.in[6] + (size_t)layer * MS * 256 + (e - (size_t)MP * 256));
            *(u32x2*)(pb + e) = f4_to_bf4(v); } }
}
__device__ __forceinline__ void shift_phase(const Params& p0) {
    const Ctx cx = mkctx(p0); Params p = p0; p.ws = cx.ws; p.out = cx.out;
    const int lane = cx.tid & 63, gw = blockIdx.x * 8 + (cx.tid >> 6), nw = gridDim.x * 8;
    const float* X = p.out + O_Y; bf16_t* xc = (bf16_t*)(p.ws + A_XCAT);
    for (int row = gw; row < MT; row += nw) {
        int b, t, T; const float* prevp; float* shout;
        if (row < MP) { b = row >> 11; t = row & 2047; T = 2048; prevp = nullptr; shout = p.out + O_SHP + (size_t)b * 1024; }
        else { const int r = row - MP; b = r >> 2; t = r & 3; T = 4; prevp = p.in[3] + (size_t)b * 1024; shout = p.out + O_SHS + (size_t)b * 1024; }
        if (t > 0) prevp = X + (size_t)(row - 1) * 1024;
#pragma unroll
        for (int i = 0; i < 4; ++i) { const int c = i * 256 + lane * 4; const f32x4 x = *(const f32x4*)(X + (size_t)row * 1024 + c);
            const f32x4 pv = prevp ? *(const f32x4*)(prevp + c) : (f32x4){0.f, 0.f, 0.f, 0.f};
            *(u32x2*)(xc + (size_t)row * 2048 + c) = f4_to_bf4(x); *(u32x2*)(xc + (size_t)row * 2048 + 1024 + c) = f4_to_bf4(pv - x);
            if (t == T - 1) *(f32x4*)(shout + c) = x; }
    }
}
__device__ __forceinline__ void lnv_phase(const Params& p0, int jA) {
    const Ctx cx = mkctx(p0); Params p = p0; p.ws = cx.ws; p.out = cx.out;
    const int lane = cx.tid & 63, gw = blockIdx.x * 8 + (cx.tid >> 6), nw = gridDim.x * 8;
    const float* V = (const float*)(p.ws + A_V); bf16_t* vn = (bf16_t*)(p.ws + A_VN);
    const float* g = p.in[15] + (size_t)jA * 2048; const float* b = p.in[16] + (size_t)jA * 2048;
    for (int row = gw; row < MP; row += nw) {
        f32x4 v[8]; float s = 0.f;
#pragma unroll
        for (int i = 0; i < 8; ++i) { v[i] = *(const f32x4*)(V + (size_t)row * 2048 + i * 256 + lane * 4); s += (v[i][0] + v[i][1]) + (v[i][2] + v[i][3]); }
        const float mean = wave_sum(s) * (1.0f / 2048.0f); float q = 0.f;
#pragma unroll
        for (int i = 0; i < 8; ++i) { v[i] = v[i] - mean; q += (v[i][0] * v[i][0] + v[i][1] * v[i][1]) + (v[i][2] * v[i][2] + v[i][3] * v[i][3]); }
        const float rstd = rsqrtf(wave_sum(q) * (1.0f / 2048.0f) + 1e-5f);
#pragma unroll
        for (int i = 0; i < 8; ++i) { const int c = i * 256 + lane * 4; const f32x4 y = v[i] * rstd * *(const f32x4*)(g + c) + *(const f32x4*)(b + c); *(u32x2*)(vn + (size_t)row * 2048 + c) = f4_to_bf4(y); }
    }
    const bf16_t* U = (const bf16_t*)(p.ws + A_U); bf16_t* yb = (bf16_t*)(p.ws + A_YB);
    const float* wsp = p.in[17] + (size_t)jA * 8 * 128 * 128; const float* bsp = p.in[18] + (size_t)jA * 8 * 128;
    for (int bb = nw - 1 - gw; bb < 128; bb += nw) {
        float mean[4], rstd[4];
#pragma unroll
        for (int t = 0; t < 4; ++t) { const int row = MP + bb * 4 + t; f32x4 v[8]; float s = 0.f;
#pragma unroll
            for (int i = 0; i < 8; ++i) { v[i] = *(const f32x4*)(V + (size_t)row * 2048 + i * 256 + lane * 4); s += (v[i][0] + v[i][1]) + (v[i][2] + v[i][3]); }
            mean[t] = wave_sum(s) * (1.0f / 2048.0f); float q = 0.f;
#pragma unroll
            for (int i = 0; i < 8; ++i) { v[i] = v[i] - mean[t]; q += (v[i][0] * v[i][0] + v[i][1] * v[i][1]) + (v[i][2] * v[i][2] + v[i][3] * v[i][3]); }
            rstd[t] = rsqrtf(wave_sum(q) * (1.0f / 2048.0f) + 1e-5f); }
        for (int i = 0; i < 8; ++i) { const int c = i * 256 + lane * 4, h = i;
            const f32x4 g4 = *(const f32x4*)(g + c), b4 = *(const f32x4*)(b + c); f32x4 n[4];
#pragma unroll
            for (int t = 0; t < 4; ++t) { const int row = MP + bb * 4 + t; n[t] = (*(const f32x4*)(V + (size_t)row * 2048 + c) - mean[t]) * rstd[t] * g4 + b4;
                *(f32x4*)(p.out + O_AV + ((size_t)jA * 512 + bb * 4 + t) * 2048 + c) = n[t]; }
#pragma unroll
            for (int t = 0; t < 4; ++t) { const int row = MP + bb * 4 + t; const float bs = bsp[h * 128 + t]; f32x4 mx = (f32x4){bs, bs, bs, bs};
#pragma unroll
                for (int s = 0; s <= t; ++s) mx += n[s] * wsp[(h * 128 + t) * 128 + s];
                const f32x4 u = bf4_to_f4(*(const u32x2*)(U + (size_t)row * 2048 + c)); *(u32x2*)(yb + (size_t)row * 2048 + c) = f4_to_bf4(u * mx); }
        }
    }
}
__device__ __forceinline__ void spatial_phase(const Params& p0, int jA, LAS unsigned char* lds) {
    const Ctx cx = mkctx(p0); Params p = p0; p.ws = cx.ws; p.out = cx.out;
    const int tid = cx.tid, wid = tid >> 6, lane = tid & 63, fr = lane & 15, fq = lane >> 4;
    const bf16_t* vn = (const bf16_t*)(p.ws + A_VN); const bf16_t* U = (const bf16_t*)(p.ws + A_U); bf16_t* yb = (bf16_t*)(p.ws + A_YB);
    const bf16_t* was = (const bf16_t*)(p.ws + W_A_S) + (size_t)jA * 8 * 128 * 128; const float* bsp = p.in[18] + (size_t)jA * 8 * 128;
    constexpr int RS = 516;
    for (int u = blockIdx.x; u < 1024; u += gridDim.x) {
        const int c = u >> 3, h = u & 7;
        __syncthreads();
        for (int i = tid; i < 128 * 32; i += 512) { const int s = i >> 5, c8 = (i & 31) * 8; const u32x4 w = *(const u32x4*)(vn + (size_t)(c * 128 + s) * 2048 + h * 256 + c8);
            LAS unsigned* d = (LAS unsigned*)(lds + s * RS + c8 * 2); d[0] = w.x; d[1] = w.y; d[2] = w.z; d[3] = w.w; }
        __syncthreads();
        bf16x8 vf[2][4];
#pragma unroll
        for (int n = 0; n < 2; ++n)
#pragma unroll
            for (int kb = 0; kb < 4; ++kb)
#pragma unroll
                for (int j = 0; j < 8; ++j) vf[n][kb][j] = (short)*(const LAS unsigned short*)(lds + (kb * 32 + fq * 8 + j) * RS + (wid * 32 + n * 16 + fr) * 2);
        for (int tb = 0; tb < 8; ++tb) {
            f32x4 acc[2]; acc[0] = (f32x4){0.f, 0.f, 0.f, 0.f}; acc[1] = acc[0];
            const bf16_t* wrow = was + (size_t)(h * 128 + tb * 16 + fr) * 128 + fq * 8;
#pragma unroll
            for (int kb = 0; kb < 4; ++kb) if (kb <= (tb >> 1)) { const bf16x8 wf = *(const bf16x8*)(wrow + kb * 32);
                acc[0] = __builtin_amdgcn_mfma_f32_16x16x32_bf16(vf[0][kb], wf, acc[0], 0, 0, 0); acc[1] = __builtin_amdgcn_mfma_f32_16x16x32_bf16(vf[1][kb], wf, acc[1], 0, 0, 0); }
            const int row = c * 128 + tb * 16 + fr; const float bs = bsp[h * 128 + tb * 16 + fr];
#pragma unroll
            for (int n = 0; n < 2; ++n) { const int col = h * 256 + wid * 32 + n * 16 + fq * 4; const f32x4 uu = bf4_to_f4(*(const u32x2*)(U + (size_t)row * 2048 + col));
                *(u32x2*)(yb + (size_t)row * 2048 + col) = f4_to_bf4(uu * (acc[n] + bs)); }
        }
    }
}
__device__ __forceinline__ void conv_phase(const Params& p0) {
    const Ctx cx = mkctx(p0); Params p = p0; p.ws = cx.ws; p.out = cx.out;
    const float* Z = (const float*)(p.ws + A_Z); const float* BG = (const float*)(p.ws + A_BG); bf16_t* yc = (bf16_t*)(p.ws + A_YC);
    const float* cw = p.in[37];
    const size_t gt = (size_t)blockIdx.x * 512 + cx.tid, gn = (size_t)gridDim.x * 512;
    for (size_t i = gt; i < (size_t)MT * 256; i += gn) {
        const int row = (int)(i >> 8), c = (int)(i & 255) * 4; int b, t, T; const float* buf; float* cvout;
        if (row < MP) { b = row >> 11; t = row & 2047; T = 2048; buf = nullptr; cvout = p.out + O_CVP + (size_t)b * 2048; }
        else { const int r = row - MP; b = r >> 2; t = r & 3; T = 4; buf = p.in[4] + (size_t)b * 2048; cvout = p.out + O_CVS + (size_t)b * 2048; }
        const f32x4 z0 = *(const f32x4*)(Z + (size_t)row * 1024 + c); const f32x4 zero = (f32x4){0.f, 0.f, 0.f, 0.f};
        const f32x4 z1 = t >= 1 ? *(const f32x4*)(Z + (size_t)(row - 1) * 1024 + c) : (buf ? *(const f32x4*)(buf + 1024 + c) : zero);
        const f32x4 z2 = t >= 2 ? *(const f32x4*)(Z + (size_t)(row - 2) * 1024 + c) : (buf ? *(const f32x4*)(buf + (size_t)t * 1024 + c) : zero);
        const f32x4 cv = *(const f32x4*)(cw + c) * z2 + *(const f32x4*)(cw + 1024 + c) * z1 + *(const f32x4*)(cw + 2048 + c) * z0;
        const f32x4 bg = *(const f32x4*)(BG + (size_t)row * 1024 + c);
        *(u32x2*)(yc + (size_t)row * 1024 + c) = f4_to_bf4(bg * cv);
        if (t >= T - 2) *(f32x4*)(cvout + (size_t)(t - (T - 2)) * 1024 + c) = z0;
    }
}
__device__ __forceinline__ void scan_unit(const Params& p0, LAS unsigned char* lds, int rowbase, int T, int h, int half0, int nhalf, const float* s0, float* sout) {
    constexpr int TC = 32, BUF = 6 * TC * 64 * 4 + 256;
    const Ctx cx = mkctx(p0); Params p = p0; p.ws = cx.ws; p.out = cx.out;
    const int tid = cx.tid, wid = tid >> 6, lane = tid & 63, ksg = lane & 15, rl = lane >> 4;
    const int hw = wid >> 2; const bool active = hw < nhalf;
    const int row0 = (half0 + hw) * 32 + (wid & 3) * 8 + rl * 2;
    const float* R = (const float*)(p.ws + A_R); const float* Kp = R + (size_t)MT * 1024; const float* Vp = Kp + (size_t)MT * 1024; const float* DEC = (const float*)(p.ws + A_DEC);
    const bf16_t* AA = (const bf16_t*)(p.ws + A_AA); float* YS = (float*)(p.ws + A_YS); float* BSg = (float*)(p.ws + A_BS);
    LAS float* Y = (LAS float*)(lds + 2 * BUF);
    const int st = tid >> 4, se = (tid & 15) * 4, hc = h * 64 + se;
    const f32x4 kk_w = *(const f32x4*)(p.in[30] + hc), ka_w = *(const f32x4*)(p.in[31] + hc), rk_w = *(const f32x4*)(p.in[32] + hc);
    f32x4 S0 = (f32x4){0.f, 0.f, 0.f, 0.f}, S1 = S0;
    if (s0 && active) { S0 = *(const f32x4*)(s0 + (size_t)row0 * 64 + ksg * 4); S1 = *(const f32x4*)(s0 + (size_t)(row0 + 1) * 64 + ksg * 4); }
    f32x4 gr, gk, gv, gd; u32x2 ga;
    const f32x4 zero = (f32x4){0.f, 0.f, 0.f, 0.f};
#define SCAN_LOAD(t0) do { const bool ok_ = (t0) + st < T; const size_t o_ = (size_t)(rowbase + (t0) + st) * 1024 + hc; \
        gr = ok_ ? *(const f32x4*)(R + o_) : zero; gk = ok_ ? *(const f32x4*)(Kp + o_) : zero; gv = ok_ ? *(const f32x4*)(Vp + o_) : zero; gd = ok_ ? *(const f32x4*)(DEC + o_) : zero; \
        ga = ok_ ? *(const u32x2*)(AA + o_) : (u32x2){0u, 0u}; } while (0)
#define SCAN_STORE(bufi, t0) do { LAS float* B_ = (LAS float*)(lds + (bufi) * BUF); const f32x4 a_ = bf4_to_f4(ga); f32x4 kkv = gk * kk_w; \
        float ss_ = (kkv[0] * kkv[0] + kkv[1] * kkv[1]) + (kkv[2] * kkv[2] + kkv[3] * kkv[3]); ss_ = red16(ss_); \
        const float inv_ = 1.0f / fmaxf(sqrtf(ss_), 1e-12f); kkv = kkv * inv_; \
        const f32x4 km_ = gk * ((a_ - 1.0f) * ka_w + 1.0f); const f32x4 rb_ = gr * km_ * rk_w; float bs_ = (rb_[0] + rb_[1]) + (rb_[2] + rb_[3]); bs_ = red16(bs_); \
        const int o_ = st * 64 + se; *(LAS f32x4*)(B_ + o_) = gd; *(LAS f32x4*)(B_ + 2048 + o_) = kkv; *(LAS f32x4*)(B_ + 4096 + o_) = kkv * a_; \
        *(LAS f32x4*)(B_ + 6144 + o_) = km_; *(LAS f32x4*)(B_ + 8192 + o_) = gr; *(LAS f32x4*)(B_ + 10240 + o_) = gv; \
        if ((tid & 15) == 0 && half0 == 0 && (t0) + st < T) BSg[(size_t)(rowbase + (t0) + st) * 16 + h] = bs_; } while (0)
    __syncthreads();
    SCAN_LOAD(0); SCAN_STORE(0, 0);
    __syncthreads();
    const int nch = (T + TC - 1) / TC;
    for (int c = 0; c < nch; ++c) {
        const int t0 = c * TC; const int nst = (T - t0) < TC ? (T - t0) : TC;
        if (c + 1 < nch) SCAN_LOAD(t0 + TC);
        const LAS float* B = (const LAS float*)(lds + (c & 1) * BUF);
        if (active) {
            f32x4 w = *(const LAS f32x4*)(B + ksg * 4), kk = *(const LAS f32x4*)(B + 2048 + ksg * 4), ka = *(const LAS f32x4*)(B + 4096 + ksg * 4);
            f32x4 km = *(const LAS f32x4*)(B + 6144 + ksg * 4), rr = *(const LAS f32x4*)(B + 8192 + ksg * 4);
            f32x2 vv = *(const LAS f32x2*)(B + 10240 + row0);
            for (int tt = 0; tt < nst; ++tt) {
                const int tn = (tt + 1 < nst ? tt + 1 : tt) * 64;
                const f32x4 wn = *(const LAS f32x4*)(B + tn + ksg * 4), kkn = *(const LAS f32x4*)(B + 2048 + tn + ksg * 4), kan = *(const LAS f32x4*)(B + 4096 + tn + ksg * 4);
                const f32x4 kmn = *(const LAS f32x4*)(B + 6144 + tn + ksg * 4), rrn = *(const LAS f32x4*)(B + 8192 + tn + ksg * 4);
                const f32x2 vvn = *(const LAS f32x2*)(B + 10240 + tn + row0);
                const f32x4 a0 = S0 * kk, a1 = S1 * kk;
                float p0 = (a0[0] + a0[1]) + (a0[2] + a0[3]);
                float p1 = (a1[0] + a1[1]) + (a1[2] + a1[3]);
                p0 = red16(p0); p1 = red16(p1);
                S0 = S0 * w - ka * p0 + km * vv.x;
                S1 = S1 * w - ka * p1 + km * vv.y;
                const f32x4 b0 = S0 * rr, b1 = S1 * rr;
                float q0 = (b0[0] + b0[1]) + (b0[2] + b0[3]);
                float q1 = (b1[0] + b1[1]) + (b1[2] + b1[3]);
                q0 = red16(q0); q1 = red16(q1);
                if (ksg == 0) *(LAS f32x2*)(Y + tt * 64 + hw * 32 + (wid & 3) * 8 + rl * 2) = (f32x2){q0, q1};
                w = wn; kk = kkn; ka = kan; km = kmn; rr = rrn; vv = vvn;
            }
        }
        __syncthreads();
        { const int nq = nhalf * 8; for (int i = tid; i < nst * nq; i += 512) { const int t = i / nq, q4 = (i - t * nq) * 4;
            *(f32x4*)(YS + (size_t)(rowbase + t0 + t) * 1024 + h * 64 + half0 * 32 + q4) = *(const LAS f32x4*)(Y + t * 64 + q4); } }
        if (c + 1 < nch) SCAN_STORE((c + 1) & 1, t0 + TC);
        __syncthreads();
    }
    if (active) { *(f32x4*)(sout + (size_t)row0 * 64 + ksg * 4) = S0; *(f32x4*)(sout + (size_t)(row0 + 1) * 64 + ksg * 4) = S1; }
#undef SCAN_LOAD
#undef SCAN_STORE
}
__device__ __forceinline__ void scan_phase(const Params& p, LAS unsigned char* lds) {
    const int G = gridDim.x, c = blockIdx.x;
    for (int u = c; u < 256; u += G) { const int bh = u >> 1, b = bh >> 4, h = bh & 15; scan_unit(p, lds, b * 2048, 2048, h, u & 1, 1, nullptr, p.out + O_WKVP + (size_t)bh * 4096); }
    for (int u = c; u < 2048; u += G) { const int b = u >> 4, h = u & 15; scan_unit(p, lds, MP + b * 4, 4, h, 0, 2, p.in[2] + (size_t)u * 4096, p.out + O_WKVS + (size_t)u * 4096); }
}
__device__ __forceinline__ void gngate_phase(const Params& p0) {
    const Ctx cx = mkctx(p0); Params p = p0; p.ws = cx.ws; p.out = cx.out;
    const float* YS = (const float*)(p.ws + A_YS); const float* Vp = (const float*)(p.ws + A_R) + (size_t)2 * MT * 1024; const float* BSg = (const float*)(p.ws + A_BS);
    const bf16_t* GG = (const bf16_t*)(p.ws + A_GG); bf16_t* outp = (bf16_t*)(p.ws + A_OUTPRE);
    const size_t gt = (size_t)blockIdx.x * 512 + cx.tid, gn = (size_t)gridDim.x * 512;
    for (size_t i0 = gt; i0 < (size_t)MT * 256; i0 += 2 * gn) {
        f32x4 y[2], v4[2], g4[2]; float bs[2]; bool ok[2];
#pragma unroll
        for (int u = 0; u < 2; ++u) { const size_t i = i0 + u * gn; ok[u] = i < (size_t)MT * 256; const size_t ii = ok[u] ? i : i0; const size_t o = ii * 4;
            y[u] = *(const f32x4*)(YS + o); v4[u] = *(const f32x4*)(Vp + o); g4[u] = bf4_to_f4(*(const u32x2*)(GG + o)); bs[u] = BSg[(ii >> 8) * 16 + ((ii & 255) >> 4)]; }
#pragma unroll
        for (int u = 0; u < 2; ++u) { const size_t i = i0 + u * gn; const int c = (int)(i & 255) * 4;
            float s = (y[u][0] + y[u][1]) + (y[u][2] + y[u][3]); s = red16(s); const float mean = s * (1.0f / 64.0f);
            const f32x4 d = y[u] - mean; float q = (d[0] * d[0] + d[1] * d[1]) + (d[2] * d[2] + d[3] * d[3]); q = red16(q);
            const float rstd = rsqrtf(q * (1.0f / 64.0f) + 64e-5f);
            const f32x4 lg = *(const f32x4*)(p.in[33] + c), lb = *(const f32x4*)(p.in[34] + c);
            if (ok[u]) *(u32x2*)(outp + i * 4) = f4_to_bf4((d * rstd * lg + lb + v4[u] * bs[u]) * g4[u]); }
    }
}

#define XB_TMO      128
#define XB_XCNT(j)  (256  + 64 * (j))
#define XB_XSUB(j)  (1280 + 64 * (j))
#define XB_XGEN(j)  (2304 + 64 * (j))
#define XB_TOP      3328
#define XB_TOPGEN   3392
#define XCD_BAR_WORDS 3456
#define XB_SPIN_CAP (1u << 18)

__device__ __forceinline__ unsigned xb_ld(unsigned* p)              { return __hip_atomic_load(p, __ATOMIC_RELAXED, __HIP_MEMORY_SCOPE_AGENT); }
__device__ __forceinline__ unsigned xb_add(unsigned* p, unsigned v) { return __hip_atomic_fetch_add(p, v, __ATOMIC_RELAXED, __HIP_MEMORY_SCOPE_AGENT); }
__device__ __forceinline__ unsigned xb_xcc_id() { return (unsigned)__builtin_amdgcn_s_getreg((3 << 11) | 20) & 0xFu; }
#define XB_SPIN(cond, bar) do { unsigned _sp = 0; while (cond) { __builtin_amdgcn_s_sleep(1); \
    if ((++_sp & 255u) == 0u) { if (xb_ld(&(bar)[XB_TMO])) break; if (_sp > XB_SPIN_CAP) { atomicAdd(&(bar)[XB_TMO], 1u); break; } } } } while (0)

struct XcdBarrier {
    unsigned* bar; unsigned x;
    volatile LAS unsigned* st;
};

__device__ __forceinline__ XcdBarrier xcd_barrier_post(unsigned* bar, volatile LAS unsigned* st) {
    XcdBarrier b; b.bar = bar; b.x = xb_xcc_id(); b.st = st;
    if (threadIdx.x == 0) (void)xb_add(&bar[XB_XCNT(b.x)], 1u);
    return b;
}
__device__ __forceinline__ void xcd_barrier_complete(unsigned* bar, unsigned x, unsigned& nloc, unsigned& nx) {
    const unsigned G = gridDim.x * gridDim.y * gridDim.z;
    unsigned sum, cnt, mine, sp = 0u;
    for (;;) {
        sum = 0u; cnt = 0u; mine = 0u;
#pragma unroll
        for (unsigned j = 0; j < 16; ++j) { const unsigned c = xb_ld(&bar[XB_XCNT(j)]); sum += c; cnt += (c > 0u) ? 1u : 0u; mine = (j == x) ? c : mine; }
        if (sum == G) break;
        __builtin_amdgcn_s_sleep(1);
        if ((++sp & 255u) == 0u) { if (xb_ld(&bar[XB_TMO])) break; if (sp > XB_SPIN_CAP) { atomicAdd(&bar[XB_TMO], 1u); break; } }
    }
    nloc = mine > 0u ? mine : 1u; nx = cnt > 0u ? cnt : 1u;
}

__device__ __forceinline__ void xcd_barrier(const XcdBarrier& b) {
    asm volatile("s_waitcnt vmcnt(0)" ::: "memory");
    __syncthreads();
    if (threadIdx.x == 0) {
        unsigned* bar = b.bar;
        __builtin_amdgcn_s_waitcnt(0);
        unsigned nloc = b.st[0], nx = b.st[1];
        if (nloc == 0u) { xcd_barrier_complete(bar, b.x, nloc, nx); b.st[0] = nloc; b.st[1] = nx; }
        const unsigned old = xb_add(&bar[XB_XSUB(b.x)], 1u);
        const unsigned gen = old / nloc;
        if (old + 1u == (gen + 1u) * nloc) {
            __builtin_amdgcn_fence(__ATOMIC_RELEASE, "agent");
            asm volatile("s_waitcnt vmcnt(0)" ::: "memory");
            const unsigned og = xb_add(&bar[XB_TOP], 1u);
            const unsigned tg = og / nx;
            if (og + 1u == (tg + 1u) * nx) xb_add(&bar[XB_TOPGEN], 1u);
            else XB_SPIN(xb_ld(&bar[XB_TOPGEN]) == tg, bar);
            __builtin_amdgcn_fence(__ATOMIC_ACQUIRE, "agent");
            xb_add(&bar[XB_XGEN(b.x)], 1u);
            asm volatile("s_waitcnt vmcnt(0)" ::: "memory");
        } else {
            XB_SPIN(xb_ld(&bar[XB_XGEN(b.x)]) == gen, bar);
            __builtin_amdgcn_fence(__ATOMIC_ACQUIRE, "agent");
            asm volatile("s_waitcnt vmcnt(0)" ::: "memory");
        }
    }
    __syncthreads();
}


enum { PT_PREP = 0, PT_GEMM, PT_LN, PT_SHIFT, PT_LNV, PT_SPATIAL, PT_CONV, PT_SCAN, PT_GNGATE };
struct Phase { int type; int ng; int a0, a1, a2; GemmDesc g[2]; };

__device__ __forceinline__ GemmDesc mk(const void* A, int lda, const void* Bt, int ldb, int K, int N, int kind, float* f0, void* h0, void* h1, const float* c0, const float* c1, float scale, int ld, int nM = MP / BM) {
    GemmDesc g; g.A = (const bf16_t*)A; g.Bt = (const bf16_t*)Bt; g.lda = lda; g.ldb = ldb; g.K = K; g.nN = N / 256;
    g.kind = kind; g.nM = nM; g.f0 = f0; g.h0 = (bf16_t*)h0; g.h1 = (bf16_t*)h1; g.c0 = c0; g.c1 = c1; g.scale = scale; g.ld = ld; g.pad = 0; return g; }

__device__ __forceinline__ void build_phase(const Params& p, int ph, Phase& P) {
    unsigned char* ws = p.ws; float* X = p.out + O_Y;
    P.ng = 0; P.a0 = P.a1 = P.a2 = 0; P.type = PT_PREP;
    if (ph == 0) return;
    int q = ph - 1, layer, step;
    if (q < 12) { layer = 0; step = q; } else if (q < 26) { layer = 1; step = q - 12; } else if (q < 37) { layer = 2; step = q - 26; } else { layer = 3; step = q - 37; }
    const int kind = layer % 3, j = layer / 3;
    const int nmix = kind == 0 ? 4 : (kind == 1 ? 6 : 3);
    const bf16_t* ffn_in0 = (const bf16_t*)(ws + W_FFN_IN) + (size_t)(layer * 2) * 5632 * 1024;
    const bf16_t* ffn_out0 = (const bf16_t*)(ws + W_FFN_OUT) + (size_t)(layer * 2) * 1024 * 2816;
    if (step == 0) { P.type = PT_GEMM; P.ng = 1; P.g[0] = mk(ws + A_XBALT, 1024, ffn_in0, 1024, 1024, 5632, EK_FFN1, nullptr, ws + A_ACT, nullptr, nullptr, nullptr, 0.f, 0, MT / BM); return; }
    if (step == 1) { P.type = PT_GEMM; P.ng = 1; P.g[0] = mk(ws + A_ACT, DFF, ffn_out0, DFF, DFF, 1024, EK_RES, X, nullptr, nullptr, nullptr, nullptr, 0.5f, 0); return; }
    if (step == 2) { P.type = PT_LN; P.a0 = layer; P.a1 = 0; P.a2 = 0; return; }
    const int ms = step - 3;
    if (ms < nmix) {
        if (kind == 0) {
            if (ms == 0) { P.type = PT_GEMM; P.ng = 1; P.g[0] = mk(ws + A_XB, 1024, (const bf16_t*)(ws + W_A_IN) + (size_t)j * 4096 * 1024, 1024, 1024, 4096, EK_GELU_UV, (float*)(ws + A_V), ws + A_U, nullptr, p.in[14] + (size_t)j * 4096, nullptr, 0.f, 0); return; }
            if (ms == 1) { P.type = PT_LNV; P.a0 = j; return; }
            if (ms == 2) { P.type = PT_SPATIAL; P.a0 = j; return; }
            P.type = PT_GEMM; P.ng = 1; P.g[0] = mk(ws + A_YB, 2048, (const bf16_t*)(ws + W_A_OUT) + (size_t)j * 1024 * 2048, 2048, 2048, 1024, EK_RES, X, nullptr, nullptr, nullptr, nullptr, 1.0f, 0); return;
        } else if (kind == 1) {
            if (ms == 0) { P.type = PT_SHIFT; return; }
            if (ms == 1) { P.type = PT_GEMM; P.ng = 1; P.g[0] = mk(ws + A_XCAT, 2048, ws + W_B_IN, 2048, 2048, 3328, EK_BIN, (float*)(ws + A_R), ws + A_T, nullptr, nullptr, nullptr, 0.f, 0, MT / BM); return; }
            if (ms == 2) { P.type = PT_GEMM; P.ng = 1; P.g[0] = mk(ws + A_T, 256, ws + W_B_L2, 256, 256, 3072, EK_BL2, (float*)(ws + A_DEC), ws + A_AA, ws + A_GG, p.in[22], p.in[25], 0.f, 0); return; }
            if (ms == 3) { P.type = PT_SCAN; return; }
            if (ms == 4) { P.type = PT_GNGATE; return; }
            P.type = PT_GEMM; P.ng = 1; P.g[0] = mk(ws + A_OUTPRE, 1024, ws + W_B_O, 1024, 1024, 1024, EK_RES, X, nullptr, nullptr, nullptr, nullptr, 1.0f, 0); return;
        } else {
            if (ms == 0) { P.type = PT_GEMM; P.ng = 2;
                P.g[0] = mk(ws + A_XB, 1024, ws + W_C_IN, 1024, 1024, 2048, EK_CONVZ, (float*)(ws + A_Z), nullptr, nullptr, nullptr, nullptr, 0.f, 0);
                P.g[1] = mk(ws + A_XB, 1024, (const bf16_t*)(ws + W_C_IN) + (size_t)2048 * 1024, 1024, 1024, 1024, EK_STORE, (float*)(ws + A_BG), nullptr, nullptr, nullptr, nullptr, 0.f, 1024); return; }
            if (ms == 1) { P.type = PT_CONV; return; }
            P.type = PT_GEMM; P.ng = 1; P.g[0] = mk(ws + A_YC, 1024, ws + W_C_OUT, 1024, 1024, 1024, EK_RES, X, nullptr, nullptr, nullptr, nullptr, 1.0f, 0); return;
        }
    }
    const int ts = ms - nmix;
    if (ts == 0) { P.type = PT_LN; P.a0 = layer; P.a1 = 1; P.a2 = 1; return; }
    if (ts == 1) { P.type = PT_GEMM; P.ng = 2;
        P.g[0] = mk(ws + A_XB, 1024, ffn_in0 + (size_t)5632 * 1024, 1024, 1024, 5632, EK_FFN1, nullptr, ws + A_ACT, nullptr, nullptr, nullptr, 0.f, 0, MT / BM);
        P.g[1] = mk(ws + A_PB, 256, (const bf16_t*)(ws + W_PLE_P) + (size_t)layer * 1024 * 256, 256, 256, 1024, EK_STORE, (float*)(ws + A_PP), nullptr, nullptr, nullptr, nullptr, 0.f, 1024); return; }
    if (ts == 2) { P.type = PT_GEMM; P.ng = 1; P.g[0] = mk(ws + A_ACT, DFF, ffn_out0 + (size_t)1024 * 2816, DFF, DFF, 1024, EK_RES, X, nullptr, nullptr, nullptr, nullptr, 0.5f, 0); return; }
    if (ts == 3) { P.type = PT_LN; P.a0 = layer; P.a1 = 2; P.a2 = 0; return; }
    P.type = PT_GEMM; P.ng = 1; P.g[0] = mk(ws + A_XB, 1024, (const bf16_t*)(ws + W_PLE_G) + (size_t)layer * 1024 * 1024, 1024, 1024, 1024, EK_PLE, X, ws + A_XBALT, nullptr, (const float*)(ws + A_PP), nullptr, 0.f, 0);
}
constexpr int NPHASES = 1 + 12 + 14 + 11 + 12;
#ifndef PROBE_MASK
#define PROBE_MASK 0
#endif

__global__ void __launch_bounds__(512) fwd_megakernel(Params p) {
    extern __shared__ __attribute__((aligned(16))) unsigned char lds_raw[];
    LAS unsigned char* lds = (LAS unsigned char*)lds_raw;
    cg::grid_group grid = cg::this_grid();
    Phase* tab = (Phase*)(p.ws + A_TAB);
    __shared__ uint4 xb_words;
    unsigned* barw = (unsigned*)(p.ws + A_BAR);
    if (threadIdx.x == 0) xb_words = make_uint4(0u, 0u, 0u, 0u);
    if (blockIdx.x == 0) for (int i = threadIdx.x; i < XCD_BAR_WORDS; i += 512) barw[i] = 0u;
    __syncthreads();
    if (blockIdx.x == 0 && threadIdx.x < NPHASES) build_phase(p, threadIdx.x, tab[threadIdx.x]);
    for (int rep = 0; rep < ((PROBE_MASK & 4) ? 2 : 1); ++rep) { prep_phase(p, lds); grid.sync(); }
    const XcdBarrier xb = xcd_barrier_post(barw, (volatile LAS unsigned*)&xb_words);
    for (int ph = 1; ph < NPHASES; ++ph) {
        const Phase* P = tab + ph;
        const int type = uload32(&P->type);
        int nrep = 1;
        if (PROBE_MASK & 1) { if (type == PT_GEMM && uload32(&P->g[0].kind) == EK_FFN1) nrep = 2; }
        if (PROBE_MASK & 2) { if (type == PT_SCAN) nrep = 2; }
        if (PROBE_MASK & 16) { if (type == PT_LNV || type == PT_SPATIAL) nrep = 2; }
        if (PROBE_MASK & 32) { if (type == PT_SHIFT || type == PT_CONV) nrep = 2; }
        for (int rep = 0; rep < nrep; ++rep) {
        if (PROBE_MASK & 8) xcd_barrier(xb);
        switch (type) {
            case PT_GEMM: { const int ng = uload32(&P->ng); for (int gi = 0; gi < ng; ++gi) { const GemmDesc* g = &P->g[gi]; if (!((PROBE_MASK & 128) && rep == 1)) gemm_big(lds, g, !((PROBE_MASK & 256) && rep == 1)); if (!((PROBE_MASK & 64) && rep == 1)) gemm_small(lds, g); } } break;
            case PT_LN: ln_phase(p, uload32(&P->a0), uload32(&P->a1), uload32(&P->a2) != 0); break;
            case PT_SHIFT: shift_phase(p); break;
            case PT_LNV: lnv_phase(p, uload32(&P->a0)); break;
            case PT_SPATIAL: spatial_phase(p, uload32(&P->a0), lds); break;
            case PT_CONV: conv_phase(p); break;
            case PT_GNGATE: gngate_phase(p); break;
            default: scan_phase(p, lds); break;
        }
        if (ph + 1 < NPHASES || rep + 1 < nrep) xcd_barrier(xb);
        }
    }
}

extern "C" void kernel_launch(void* const* d_in, const int* in_sizes, int n_in, void* d_out, int out_size, void* d_ws, size_t ws_size, hipStream_t stream) {
    static int grid_blocks = 0;
    if (grid_blocks == 0) {
        if (n_in != 39 || ws_size < WS_END) { fprintf(stderr, "kernel_launch: need 39 inputs and %zu bytes of workspace, got %d / %zu\n", (size_t)WS_END, n_in, ws_size); grid_blocks = -1; return; }
        int dev = 0, cus = 0, per_cu = 0;
        hipGetDevice(&dev); hipDeviceGetAttribute(&cus, hipDeviceAttributeMultiprocessorCount, dev);
        if (hipFuncSetAttribute((const void*)fwd_megakernel, hipFuncAttributeMaxDynamicSharedMemorySize, LDS_BYTES) != hipSuccess) { fprintf(stderr, "kernel_launch: hipFuncSetAttribute failed\n"); grid_blocks = -1; return; }
        hipOccupancyMaxActiveBlocksPerMultiprocessor(&per_cu, (const void*)fwd_megakernel, 512, LDS_BYTES);
        if (per_cu < 1) { fprintf(stderr, "kernel_launch: occupancy query says %d blocks per CU\n", per_cu); per_cu = 1; }
        (void)hipGetLastError();
        grid_blocks = cus;
    }
    if (grid_blocks < 0) return;
    Params p{};
    for (int i = 0; i < 39; ++i) p.in[i] = (const float*)d_in[i];
    p.out = (float*)d_out; p.ws = (unsigned char*)d_ws;
    void* args[] = {&p};
    hipError_t e = hipLaunchCooperativeKernel((const void*)fwd_megakernel, dim3(grid_blocks), dim3(512), args, LDS_BYTES, stream);
    if (e != hipSuccess) fprintf(stderr, "cooperative launch failed: %s (grid %d)\n", hipGetErrorString(e), grid_blocks);
}
```
